# Optimizing an MI355X kernel written in HIP

```python
import math
import jax, jax.numpy as jnp
from jax import lax
import numpy as np

D_MODEL = 1024
BATCH = 32
SEQ = 2048
DEPTH = 2
DEC_BATCH = 8
DEC_SEQ = 16
PAST_LEN = 2048

CHUNK = 64
Q_BLOCK = 128
EPS = 1e-6
NEG = -1e30
F_MIN = 1e-12
MLA_HEADS = 8
MLA_NOPE = 64
MLA_ROPE = 32
MLA_V = 64
MLA_Q_LORA = 384
MLA_KV_LORA = 256
ROPE_THETA = 10000.0
MLA_SCALE = (MLA_NOPE + MLA_ROPE) ** -0.5
HG_HEADS = 8
HG_DK = 64
HG_DV = 64
HG_BLOCK = 16
DF_HEADS = 8
DF_DH = 32
DF_DV = 2 * DF_DH
DF_SCALE = DF_DH ** -0.5
N_BRANCH = 3
BR_WIDTH = 512
D_FF = 2816
CONV_W = 3
IN_SIZES = (MLA_Q_LORA, MLA_KV_LORA, MLA_ROPE,
            HG_HEADS * HG_DK, HG_HEADS * HG_DK, HG_HEADS * HG_DV, HG_HEADS * HG_DV,
            DF_HEADS * 2 * DF_DH, DF_HEADS * 2 * DF_DH, DF_HEADS * DF_DV,
            N_BRANCH * D_MODEL)
IN_COLS = sum(IN_SIZES)

kernel_name = 'hybrid_stream_mla_hgrn2_diffattn'


def _rms(x, g):
    xf = x.astype(jnp.float32)
    r = lax.rsqrt(jnp.mean(xf * xf, axis=-1, keepdims=True) + EPS)
    return (xf * r).astype(x.dtype) * g


def _split_cols(z):
    out, start = [], 0
    for n in IN_SIZES:
        out.append(z[..., start:start + n])
        start += n
    return out


def _rope(x, pos):
    half = MLA_ROPE // 2
    inv = ROPE_THETA ** (-jnp.arange(half, dtype=jnp.float32) / half)
    ang = pos.astype(jnp.float32)[:, None] * inv[None, :]
    ang = ang.reshape((1, pos.shape[0]) + (1,) * (x.ndim - 3) + (half,))
    cos, sin = jnp.cos(ang), jnp.sin(ang)
    x1 = x[..., :half].astype(jnp.float32)
    x2 = x[..., half:].astype(jnp.float32)
    return jnp.concatenate([x1 * cos - x2 * sin, x2 * cos + x1 * sin], axis=-1).astype(x.dtype)


def _chunk_mask(q_pos, k_pos):
    return (k_pos[None, :] // CHUNK) <= (q_pos[:, None] // CHUNK)


def _over_query_blocks(fn, q_pos, qs):
    T = q_pos.shape[0]
    if T > Q_BLOCK and T % Q_BLOCK == 0:
        nb = T // Q_BLOCK
        pos_b = q_pos.reshape(nb, Q_BLOCK)
        qs_b = tuple(jnp.moveaxis(q.reshape((q.shape[0], nb, Q_BLOCK) + q.shape[2:]), 1, 0) for q in qs)
        out = lax.map(lambda a: fn(a[0], *a[1]), (pos_b, qs_b))
        out = jnp.moveaxis(out, 0, 1)
        return out.reshape((out.shape[0], T) + out.shape[3:])
    return fn(q_pos, *qs)


def _hgrn2(q, k, v, logf, S0):
    B, T, H, DK = q.shape
    DV = v.shape[-1]
    n = -(-T // HG_BLOCK)
    pad = n * HG_BLOCK - T

    def prep(a):
        a = jnp.pad(a.astype(jnp.float32), ((0, 0), (0, pad), (0, 0), (0, 0)))
        return jnp.moveaxis(a.reshape(B, n, HG_BLOCK, H, a.shape[-1]), 1, 0)

    tril = jnp.tril(jnp.ones((HG_BLOCK, HG_BLOCK), dtype=bool))[None, :, :, None, None]

    def step(S, blk):
        qb, kb, vb, gb = blk
        b = jnp.cumsum(gb, axis=1)
        o_inter = jnp.einsum('blhk,bhkv->blhv', qb * jnp.exp(b), S)
        d = b[:, :, None] - b[:, None, :]
        dec = jnp.where(tril, jnp.exp(jnp.where(tril, d, 0.0)), 0.0)
        att = jnp.einsum('bthk,btshk,bshk->bhts', qb, dec, kb)
        o_intra = jnp.einsum('bhts,bshv->bthv', att, vb)
        b_last = b[:, -1]
        S = jnp.exp(b_last)[..., None] * S + jnp.einsum(
            'bshk,bshv->bhkv', kb * jnp.exp(b_last[:, None] - b), vb)
        return S, o_inter + o_intra

    S, o = lax.scan(step, S0.astype(jnp.float32), (prep(q), prep(k), prep(v), prep(logf)))
    o = jnp.moveaxis(o, 0, 1).reshape(B, n * HG_BLOCK, H, DV)[:, :T]
    return o.astype(v.dtype), S


def _layer(l, x, pos, past, S0, conv0, lb, prm):
    (norm_mix_g, w_in, mla_q_norm_g, mla_w_uq, mla_kv_norm_g, mla_w_ukv, hgrn_norm_g,
     diff_lambda, diff_norm_g, w_branch, w_out, norm_ffn_g, ffn_w_up, ffn_conv_w,
     ffn_conv_b, ffn_w_down) = prm
    B, T, _ = x.shape
    h = _rms(x, norm_mix_g)
    z = h @ w_in
    q_lat, kv_lat, k_rot, hq, hf, hi, hg, dq, dk, dv, gate = _split_cols(z)

    q = (_rms(q_lat, mla_q_norm_g) @ mla_w_uq).reshape(B, T, MLA_HEADS, MLA_NOPE + MLA_ROPE)
    q_nope = q[..., :MLA_NOPE]
    q_rot = _rope(q[..., MLA_NOPE:], pos)
    ckv_new = _rms(kv_lat, mla_kv_norm_g)
    krot_new = _rope(k_rot, pos)
    if past is None:
        key_pos = pos
        ckv_all, krot_all = ckv_new, krot_new
        dk_all_flat = dk.reshape(B, T, DF_HEADS, 2 * DF_DH)
        dv_all = dv.reshape(B, T, DF_HEADS, DF_DV)
    else:
        key_pos = jnp.arange(past[0].shape[1] + T)
        ckv_all = jnp.concatenate([past[0], ckv_new], axis=1)
        krot_all = jnp.concatenate([past[1], krot_new], axis=1)
        dk_all_flat = jnp.concatenate([past[2], dk.reshape(B, T, DF_HEADS, 2 * DF_DH)], axis=1)
        dv_all = jnp.concatenate([past[3], dv.reshape(B, T, DF_HEADS, DF_DV)], axis=1)
    K = key_pos.shape[0]
    kv = (ckv_all @ mla_w_ukv).reshape(B, K, MLA_HEADS, MLA_NOPE + MLA_V)
    k_nope, v_mla = kv[..., :MLA_NOPE], kv[..., MLA_NOPE:]

    def mla_fn(qp, qn, qr):
        s = (jnp.einsum('bqhd,bkhd->bhqk', qn, k_nope)
             + jnp.einsum('bqhr,bkr->bhqk', qr, krot_all)).astype(jnp.float32) * MLA_SCALE
        s = jnp.where(_chunk_mask(qp, key_pos), s, NEG)
        p = jax.nn.softmax(s, axis=-1).astype(v_mla.dtype)
        return jnp.einsum('bhqk,bkhd->bqhd', p, v_mla)

    o_a = _over_query_blocks(mla_fn, pos, (q_nope, q_rot)).reshape(B, T, BR_WIDTH)

    fpre = hf.astype(jnp.float32).reshape(B, T, HG_HEADS, HG_DK)
    lbh = lb.reshape(HG_HEADS, HG_DK)
    sig_neg = jax.nn.sigmoid(-fpre)
    f_h = jax.nn.sigmoid(fpre) + lbh * sig_neg
    logf = jnp.log(jnp.maximum(f_h, F_MIN))
    k_h = (1.0 - lbh) * sig_neg
    q_h = jax.nn.silu(hq).reshape(B, T, HG_HEADS, HG_DK)
    v_h = hi.reshape(B, T, HG_HEADS, HG_DV)
    o_h, S_new = _hgrn2(q_h, k_h, v_h, logf, S0)
    o_b = (_rms(o_h, hgrn_norm_g) * jax.nn.silu(hg).reshape(B, T, HG_HEADS, HG_DV)).reshape(B, T, BR_WIDTH)

    lam_init = 0.8 - 0.6 * math.exp(-0.3 * l)
    lamf = diff_lambda.astype(jnp.float32)
    lam = jnp.exp(jnp.sum(lamf[0] * lamf[1])) - jnp.exp(jnp.sum(lamf[2] * lamf[3])) + lam_init
    dq_h = dq.reshape(B, T, DF_HEADS, 2, DF_DH)
    dk_all = dk_all_flat.reshape(B, K, DF_HEADS, 2, DF_DH)

    def diff_fn(qp, qd):
        s = jnp.einsum('bqhjd,bkhjd->bjhqk', qd, dk_all).astype(jnp.float32) * DF_SCALE
        s = jnp.where(_chunk_mask(qp, key_pos), s, NEG)
        p = jax.nn.softmax(s, axis=-1)
        a = (p[:, 0] - lam * p[:, 1]).astype(dv_all.dtype)
        return jnp.einsum('bhqk,bkhd->bqhd', a, dv_all)

    o_c = _over_query_blocks(diff_fn, pos, (dq_h,))
    o_c = (_rms(o_c, diff_norm_g) * (1.0 - lam_init)).reshape(B, T, BR_WIDTH)

    g = jax.nn.sigmoid(gate.astype(jnp.float32)).astype(x.dtype).reshape(B, T, N_BRANCH, D_MODEL)
    br = jnp.stack([o_a, o_b, o_c], axis=2)
    proj = jnp.einsum('btnw,nwd->btnd', br, w_branch)
    x = x + jnp.sum(g * proj, axis=2) @ w_out

    u = _rms(x, norm_ffn_g) @ ffn_w_up
    a_up, v_up = u[..., :D_FF], u[..., D_FF:]
    ext = jnp.concatenate([conv0.astype(a_up.dtype), a_up], axis=1)
    c = ffn_conv_b + sum(ext[:, j:j + T] * ffn_conv_w[j] for j in range(CONV_W))
    x = x + (jax.nn.silu(c) * v_up) @ ffn_w_down
    conv_new = ext[:, T:]

    return x, (ckv_new, krot_new, dk.reshape(B, T, DF_HEADS, 2 * DF_DH),
               dv.reshape(B, T, DF_HEADS, DF_DV), S_new, conv_new)


def _nrm(k, shape, scale):
    return jax.random.normal(k, shape, jnp.float32) * scale


def setup_inputs(seed: int = 0) -> dict:
    key = jax.random.key(seed)
    ks = jax.random.split(key, 26)
    return {
        'x_prompt': _nrm(ks[0], (BATCH, SEQ, D_MODEL), 1.0),
        'x_sample': _nrm(ks[1], (DEC_BATCH, DEC_SEQ, D_MODEL), 1.0),
        'cache_mla_ckv': _nrm(ks[2], (DEPTH, DEC_BATCH, PAST_LEN, MLA_KV_LORA), 1.0),
        'cache_mla_krope': _nrm(ks[3], (DEPTH, DEC_BATCH, PAST_LEN, MLA_ROPE), 1.0),
        'cache_diff_k': _nrm(ks[4], (DEPTH, DEC_BATCH, PAST_LEN, DF_HEADS, 2 * DF_DH), 1.0),
        'cache_diff_v': _nrm(ks[5], (DEPTH, DEC_BATCH, PAST_LEN, DF_HEADS, DF_DV), 1.0),
        'state_hgrn': _nrm(ks[6], (DEPTH, DEC_BATCH, HG_HEADS, HG_DK, HG_DV), 0.5),
        'state_ffn_conv': _nrm(ks[7], (DEPTH, DEC_BATCH, CONV_W - 1, D_FF), 1.0),
        'norm_mix_g': 1.0 + _nrm(ks[8], (DEPTH, D_MODEL), 0.01),
        'w_in': _nrm(ks[9], (DEPTH, D_MODEL, IN_COLS), D_MODEL ** -0.5),
        'mla_q_norm_g': 1.0 + _nrm(ks[10], (DEPTH, MLA_Q_LORA), 0.01),
        'mla_w_uq': _nrm(ks[11], (DEPTH, MLA_Q_LORA, MLA_HEADS * (MLA_NOPE + MLA_ROPE)), MLA_Q_LORA ** -0.5),
        'mla_kv_norm_g': 1.0 + _nrm(ks[12], (DEPTH, MLA_KV_LORA), 0.01),
        'mla_w_ukv': _nrm(ks[13], (DEPTH, MLA_KV_LORA, MLA_HEADS * (MLA_NOPE + MLA_V)), MLA_KV_LORA ** -0.5),
        'hgrn_lb_logits': _nrm(ks[14], (DEPTH, HG_HEADS * HG_DK), 1.0),
        'hgrn_norm_g': 1.0 + _nrm(ks[15], (DEPTH, HG_DV), 0.01),
        'diff_lambda': _nrm(ks[16], (DEPTH, 4, DF_DH), 0.1),
        'diff_norm_g': 1.0 + _nrm(ks[17], (DEPTH, DF_DV), 0.01),
        'w_branch': _nrm(ks[18], (DEPTH, N_BRANCH, BR_WIDTH, D_MODEL), BR_WIDTH ** -0.5),
        'w_out': _nrm(ks[19], (DEPTH, D_MODEL, D_MODEL), D_MODEL ** -0.5),
        'norm_ffn_g': 1.0 + _nrm(ks[20], (DEPTH, D_MODEL), 0.01),
        'ffn_w_up': _nrm(ks[21], (DEPTH, D_MODEL, 2 * D_FF), D_MODEL ** -0.5),
        'ffn_conv_w': _nrm(ks[22], (DEPTH, CONV_W, D_FF), CONV_W ** -0.5),
        'ffn_conv_b': _nrm(ks[23], (DEPTH, D_FF), 0.01),
        'ffn_w_down': _nrm(ks[24], (DEPTH, D_FF, D_MODEL), D_FF ** -0.5),
        'norm_final_g': 1.0 + _nrm(ks[25], (D_MODEL,), 0.01),
    }


def _stack(states, i):
    return jnp.stack([s[i] for s in states], axis=0)


def reference(x_prompt, x_sample, cache_mla_ckv, cache_mla_krope, cache_diff_k, cache_diff_v,
              state_hgrn, state_ffn_conv, norm_mix_g, w_in, mla_q_norm_g, mla_w_uq, mla_kv_norm_g,
              mla_w_ukv, hgrn_lb_logits, hgrn_norm_g, diff_lambda, diff_norm_g, w_branch, w_out,
              norm_ffn_g, ffn_w_up, ffn_conv_w, ffn_conv_b, ffn_w_down, norm_final_g):
    B, T = x_prompt.shape[0], x_prompt.shape[1]
    Ts = x_sample.shape[1]
    P = cache_mla_ckv.shape[2]
    pos_p = jnp.arange(T)
    pos_s = P + jnp.arange(Ts)
    lb_soft = jax.nn.softmax(hgrn_lb_logits.astype(jnp.float32), axis=0)
    lb_all = jnp.cumsum(lb_soft, axis=0) - lb_soft[0]
    yp, ys = x_prompt, x_sample
    sp, ss = [], []
    for l in range(DEPTH):
        prm = (norm_mix_g[l], w_in[l], mla_q_norm_g[l], mla_w_uq[l], mla_kv_norm_g[l], mla_w_ukv[l],
               hgrn_norm_g[l], diff_lambda[l], diff_norm_g[l], w_branch[l], w_out[l], norm_ffn_g[l],
               ffn_w_up[l], ffn_conv_w[l], ffn_conv_b[l], ffn_w_down[l])
        yp, st_p = _layer(l, yp, pos_p, None,
                          jnp.zeros((B, HG_HEADS, HG_DK, HG_DV), jnp.float32),
                          jnp.zeros((B, CONV_W - 1, D_FF), x_prompt.dtype), lb_all[l], prm)
        sp.append(st_p)
        ys, st_s = _layer(l, ys, pos_s,
                          (cache_mla_ckv[l], cache_mla_krope[l], cache_diff_k[l], cache_diff_v[l]),
                          state_hgrn[l], state_ffn_conv[l], lb_all[l], prm)
        ss.append(st_s)
    y_prompt = _rms(yp, norm_final_g)
    y_sample = _rms(ys, norm_final_g)
    p_ckv, p_krope, p_dk, p_dv = _stack(sp, 0), _stack(sp, 1), _stack(sp, 2), _stack(sp, 3)
    p_hgrn, p_conv = _stack(sp, 4), _stack(sp, 5)
    s_ckv, s_krope, s_dk, s_dv = _stack(ss, 0), _stack(ss, 1), _stack(ss, 2), _stack(ss, 3)
    s_hgrn, s_conv = _stack(ss, 4), _stack(ss, 5)
    return (y_prompt, y_sample, p_ckv, p_krope, p_dk, p_dv, p_hgrn, p_conv,
            s_ckv, s_krope, s_dk, s_dv, s_hgrn, s_conv)
```

```cpp
#include <hip/hip_runtime.h>
#include <hip/hip_cooperative_groups.h>
#include <cstdio>
#include <cstdint>
namespace cg = cooperative_groups;

typedef unsigned short bf16_t;
typedef short bf16x8 __attribute__((ext_vector_type(8)));
typedef float f32x4 __attribute__((ext_vector_type(4)));
typedef float f32x2 __attribute__((ext_vector_type(2)));
typedef unsigned u32x4 __attribute__((ext_vector_type(4)));
typedef unsigned u32x2 __attribute__((ext_vector_type(2)));
#define DI __device__ __forceinline__
#define LANEVARS const int tid = opq((int)threadIdx.x), lane = tid & 63, wave = tid >> 6, wr = wave >> 1, wc = wave & 1, fr = lane & 15, fq = lane >> 4; (void)lane; (void)wave; (void)wr; (void)wc; (void)fr; (void)fq;
#define MFMA16(a, b, c) __builtin_amdgcn_mfma_f32_16x16x32_bf16((a), (b), (c), 0, 0, 0)

constexpr int NPTOK = 65536, NSTOK = 128;
constexpr int KS_LD = 2112;
constexpr float EPS = 1e-6f;
constexpr float LOG2E = 1.4426950408889634f;
constexpr float QS_MLA = 0.10206207261596577f * LOG2E;
constexpr float QS_DF = 0.17677669529663687f * LOG2E;
constexpr int DFF = 2816;
constexpr int LDS_BYTES = 73728;
constexpr int MAXGRID = 512;
#ifndef DRY4
#define DRY4 0
#endif
#ifndef REP2
#define REP2 1
#endif
#ifndef REP7
#define REP7 1
#endif
#ifndef PH
#define PH 0x1ff
#endif

constexpr size_t O_YP = 0;
constexpr size_t O_YS = O_YP + (size_t)NPTOK * 1024;
constexpr size_t O_PCKV = O_YS + (size_t)NSTOK * 1024;
constexpr size_t O_PKR = O_PCKV + (size_t)2 * NPTOK * 256;
constexpr size_t O_PDK = O_PKR + (size_t)2 * NPTOK * 32;
constexpr size_t O_PDV = O_PDK + (size_t)2 * NPTOK * 512;
constexpr size_t O_PHG = O_PDV + (size_t)2 * NPTOK * 512;
constexpr size_t O_PCONV = O_PHG + (size_t)2 * 32 * 8 * 64 * 64;
constexpr size_t O_SCKV = O_PCONV + (size_t)2 * 32 * 2 * DFF;
constexpr size_t O_SKR = O_SCKV + (size_t)2 * NSTOK * 256;
constexpr size_t O_SDK = O_SKR + (size_t)2 * NSTOK * 32;
constexpr size_t O_SDV = O_SDK + (size_t)2 * NSTOK * 512;
constexpr size_t O_SHG = O_SDV + (size_t)2 * NSTOK * 512;
constexpr size_t O_SCONV = O_SHG + (size_t)2 * 8 * 8 * 64 * 64;

struct Params {
  const float* in[26];
  float* out;
  char* ws;
  int ng;
  int pad;
};

struct Layout {
  size_t w_in, w_g, w_uq, w_ukvG, w_ukvP, w_br, w_out, w_up, w_down, rope, ctr, bar, xb, ssq0, ssq1, ssqq, ssqkv, qlat, q, kvlat, krot, kv,
      hq, hf, hi, hg, dq, dk, dvT, ckvS, knopeS, vtMS, krotS, dKS, dVtS, gst, total;
};
__host__ __device__ __forceinline__ size_t al256(size_t b) { return (b + 255) & ~(size_t)255; }
__host__ __device__ __forceinline__ void make_layout(int ng, Layout& L) {
  size_t o = 0;
  const size_t TG = (size_t)(32 / ng) * 2048, R = TG + 128;
#define TAKE(field, bytes) L.field = o; o += al256((size_t)(bytes));
  TAKE(w_in, 4352 * 1024 * 2) TAKE(w_g, 3072 * 1024 * 2) TAKE(w_uq, 768 * 384 * 2) TAKE(w_ukvG, 1024 * 256 * 2) TAKE(w_ukvP, 1024 * 256 * 2)
  TAKE(w_br, 3 * 1024 * 512 * 2) TAKE(w_out, 1024 * 1024 * 2) TAKE(w_up, 5632 * 1024 * 2) TAKE(w_down, 1024 * 2816 * 2)
  TAKE(rope, 2064 * 16 * 8) TAKE(ctr, 256) TAKE(bar, 16384)
  TAKE(xb, (size_t)(NPTOK + NSTOK) * 1024 * 2) TAKE(ssq0, (size_t)(NPTOK + NSTOK) * 16 * 4) TAKE(ssq1, (size_t)(NPTOK + NSTOK) * 16 * 4)
  TAKE(ssqq, R * 8 * 4) TAKE(ssqkv, R * 4 * 4)
  TAKE(qlat, R * 384 * 2) TAKE(kvlat, R * 256 * 2) TAKE(q, R * 768 * 2) TAKE(krot, R * 32 * 2)
  TAKE(kv, R * 2048)
  TAKE(hq, R * 1024) TAKE(hf, R * 1024) TAKE(hi, R * 1024) TAKE(hg, R * 1024) TAKE(dq, R * 1024) TAKE(dk, R * 1024) TAKE(dvT, R * 1024)
  TAKE(ckvS, 16384 * 256 * 2) TAKE(knopeS, 8 * KS_LD * 512 * 2) TAKE(vtMS, 8 * 512 * KS_LD * 2) TAKE(krotS, 8 * KS_LD * 32 * 2)
  TAKE(dKS, 8 * KS_LD * 512 * 2) TAKE(dVtS, 8 * 512 * KS_LD * 2)
  if (ng == 1) { L.gst = L.qlat; } else { TAKE(gst, (size_t)MAXGRID * 131072) }
#undef TAKE
  L.total = o;
}

DI int opq(int x) { asm volatile("" : "+v"(x)); return x; }
DI unsigned pk2(float lo, float hi) { unsigned r; asm("v_cvt_pk_bf16_f32 %0, %1, %2" : "=v"(r) : "v"(lo), "v"(hi)); return r; }
DI u32x2 pk4(f32x4 v) { u32x2 r; r.x = pk2(v.x, v.y); r.y = pk2(v.z, v.w); return r; }
DI float sigm(float x) { return 1.f / (1.f + __expf(-x)); }
DI float silu(float x) { return x * sigm(x); }
DI float ex2(float x) { return __builtin_amdgcn_exp2f(x); }
DI float dot4(f32x4 v) { return (v.x * v.x + v.y * v.y) + (v.z * v.z + v.w * v.w); }
DI float quadsum(float s) { s += __shfl_xor(s, 16); s += __shfl_xor(s, 32); return s; }
DI float quadmax(float s) { s = fmaxf(s, __shfl_xor(s, 16)); s = fmaxf(s, __shfl_xor(s, 32)); return s; }
DI float rowscale16(const float* ssq, int xrow) {
  const f32x4* p = (const f32x4*)(ssq + (size_t)xrow * 16);
  f32x4 a = p[0], b = p[1], c = p[2], d = p[3];
  float s = (((a.x + a.y) + (a.z + a.w)) + ((b.x + b.y) + (b.z + b.w))) + (((c.x + c.y) + (c.z + c.w)) + ((d.x + d.y) + (d.z + d.w)));
  return rsqrtf(s * (1.f / 1024.f) + EPS);
}
DI float rowscale_kv(const float* ssqkv, int rl) {
  f32x4 a = *(const f32x4*)(ssqkv + (size_t)rl * 4);
  return rsqrtf(((a.x + a.y) + (a.z + a.w)) * (1.f / 256.f) + EPS);
}

constexpr int LDT_B = 144;
constexpr int TILE_B = 128 * LDT_B;
template <bool MODEN, bool CLAMP = false>
DI void gemm_tile(const bf16_t* __restrict__ A, int lda, const bf16_t* __restrict__ B, int ldb, int K, f32x4 (&acc)[4][4], char* lds, int aro = 0, int arlo = 0, int arhi = 1 << 30) {
  const int tid = opq((int)threadIdx.x), lane = tid & 63, wave = tid >> 6, wr = wave >> 1, wc = wave & 1, fr = lane & 15, fq = lane >> 4;
  const int lrow = tid >> 3, lkc = tid & 7;
  const bf16_t* ap[4];
#pragma unroll
  for (int i = 0; i < 4; ++i) {
    if (CLAMP) { int Ra = lrow + 32 * i + aro; Ra = Ra < arlo ? arlo : (Ra > arhi ? arhi : Ra); ap[i] = A + (ptrdiff_t)Ra * lda + lkc * 8; }
    else ap[i] = A + (size_t)lrow * lda + lkc * 8 + (size_t)(32 * i) * lda;
  }
  const bf16_t* bp = B + (size_t)lrow * ldb + lkc * 8;
  const int st_off = lrow * LDT_B + lkc * 16;
  const int a_off = (wr * 64 + fr) * LDT_B + fq * 16;
  const int b_off = TILE_B + (wc * 64 + fr) * LDT_B + fq * 16;
  u32x4 ra0[4], rb0[4], ra1[4], rb1[4];
#define G_LOAD(RA, RB, ko) _Pragma("unroll") for (int i = 0; i < 4; ++i) { RA[i] = *(const u32x4*)(ap[i] + (ko)); RB[i] = *(const u32x4*)(bp + (size_t)(32 * i) * ldb + (ko)); }
#define G_STORE(RA, RB, base) _Pragma("unroll") for (int i = 0; i < 4; ++i) { *(u32x4*)(lds + (base) + st_off + i * 32 * LDT_B) = RA[i]; *(u32x4*)(lds + (base) + TILE_B + st_off + i * 32 * LDT_B) = RB[i]; }
#define G_COMPUTE(base) _Pragma("unroll") for (int ks = 0; ks < 2; ++ks) { \
      bf16x8 af[4], bfr[4]; \
      _Pragma("unroll") for (int i = 0; i < 4; ++i) { af[i] = *(const bf16x8*)(lds + (base) + a_off + i * 16 * LDT_B + ks * 64); bfr[i] = *(const bf16x8*)(lds + (base) + b_off + i * 16 * LDT_B + ks * 64); } \
      _Pragma("unroll") for (int mi = 0; mi < 4; ++mi) _Pragma("unroll") for (int ni = 0; ni < 4; ++ni) acc[mi][ni] = MODEN ? MFMA16(af[mi], bfr[ni], acc[mi][ni]) : MFMA16(bfr[ni], af[mi], acc[mi][ni]); }
  G_LOAD(ra0, rb0, 0)
  G_LOAD(ra1, rb1, 64)
  G_STORE(ra0, rb0, 0)
  __syncthreads();
  const int nk = K >> 6;
  for (int kt = 0; kt < nk; kt += 2) {
    if (kt + 2 < nk) { G_LOAD(ra0, rb0, (kt + 2) * 64) }
    G_COMPUTE(0)
    G_STORE(ra1, rb1, 2 * TILE_B)
    __syncthreads();
    if (kt + 3 < nk) { G_LOAD(ra1, rb1, (kt + 3) * 64) }
    G_COMPUTE(2 * TILE_B)
    if (kt + 2 < nk) { G_STORE(ra0, rb0, 0) }
    __syncthreads();
  }
#undef G_LOAD
#undef G_STORE
#undef G_COMPUTE
}
constexpr int OPT_B = 8192, SLOT3_B = 24576;
DI int lds_byte32(int r, int c) { const int ob = (r & 15) * 64 + c * 2; return (r >> 4) * 1024 + (ob ^ (((ob >> 9) & 1) << 5)); }
DI void stage_rc32(int b, int& R, int& C) { const int sb = b & 1023, swz = sb ^ (((sb >> 9) & 1) << 5); R = (b >> 10) * 16 + (swz >> 6); C = (swz & 63) >> 1; }
template <bool CLAMP = false>
DI void gemm_pair(const bf16_t* __restrict__ A0, const bf16_t* __restrict__ A1, int lda, const bf16_t* __restrict__ B, int ldb, int K,
                  f32x4 (&acc0)[4][4], f32x4 (&acc1)[4][4], char* lds, int aro0 = 0, int aro1 = 0, int arlo = 0, int arhi = 1 << 30) {
  const int tid = opq((int)threadIdx.x), lane = tid & 63, wave = tid >> 6, wr = wave >> 1, wc = wave & 1, fr = lane & 15, fq = lane >> 4;
  const bf16_t* g0[2]; const bf16_t* g1[2]; const bf16_t* gb[2];
#pragma unroll
  for (int i = 0; i < 2; ++i) {
    int R, C; stage_rc32(tid * 16 + i * 4096, R, C);
    int R0 = R, R1 = R;
    if (CLAMP) { R0 = R + aro0; R0 = R0 < arlo ? arlo : (R0 > arhi ? arhi : R0); R1 = R + aro1; R1 = R1 < arlo ? arlo : (R1 > arhi ? arhi : R1); }
    g0[i] = A0 + (size_t)R0 * lda + C; g1[i] = A1 + (size_t)R1 * lda + C; gb[i] = B + (size_t)R * ldb + C;
  }
  const int fo = lds_byte32(fr, fq * 8);
  const int a_base = wr * 4096 + fo, b_base = 2 * OPT_B + wc * 4096 + fo;
#define P_STAGE(sb, ko) _Pragma("unroll") for (int i = 0; i < 2; ++i) { \
    __builtin_amdgcn_global_load_lds((const unsigned*)(g0[i] + (ko)), (__attribute__((address_space(3))) unsigned*)(lds + (sb) + tid * 16 + i * 4096), 16, 0, 0); \
    __builtin_amdgcn_global_load_lds((const unsigned*)(g1[i] + (ko)), (__attribute__((address_space(3))) unsigned*)(lds + (sb) + OPT_B + tid * 16 + i * 4096), 16, 0, 0); \
    __builtin_amdgcn_global_load_lds((const unsigned*)(gb[i] + (ko)), (__attribute__((address_space(3))) unsigned*)(lds + (sb) + 2 * OPT_B + tid * 16 + i * 4096), 16, 0, 0); }
  const int nk = K >> 5;
  P_STAGE(0, 0)
  P_STAGE(SLOT3_B, 32)
  int cur = 0, nxt2 = 2 * SLOT3_B;
  for (int kt = 0; kt < nk; ++kt) {
    if (kt + 1 < nk) asm volatile("s_waitcnt vmcnt(6) lgkmcnt(0)" ::: "memory"); else asm volatile("s_waitcnt vmcnt(0) lgkmcnt(0)" ::: "memory");
    __builtin_amdgcn_s_barrier();
    if (kt + 2 < nk) { P_STAGE(nxt2, (kt + 2) * 32) }
    bf16x8 a0f[4], a1f[4], bfr[4];
#pragma unroll
    for (int i = 0; i < 4; ++i) { a0f[i] = *(const bf16x8*)(lds + cur + a_base + i * 1024); a1f[i] = *(const bf16x8*)(lds + cur + OPT_B + a_base + i * 1024); bfr[i] = *(const bf16x8*)(lds + cur + b_base + i * 1024); }
#pragma unroll
    for (int mi = 0; mi < 4; ++mi)
#pragma unroll
      for (int ni = 0; ni < 4; ++ni) { acc0[mi][ni] = MFMA16(bfr[ni], a0f[mi], acc0[mi][ni]); acc1[mi][ni] = MFMA16(bfr[ni], a1f[mi], acc1[mi][ni]); }
    const int t = cur; cur = (cur == 2 * SLOT3_B) ? 0 : cur + SLOT3_B; nxt2 = t;
  }
  __syncthreads();
#undef P_STAGE
}
DI bool map_tile(int it, int bid, int nblk, int NT, int MT, int& mt, int& nt) {
  const int tp = (it * 8 + (bid & 7)) * (nblk >> 3) + (bid >> 3);
  const int per = NT * 8;
  const int mg = tp / per, r = tp - mg * per;
  nt = r >> 3; mt = mg * 8 + (r & 7);
  return mt < MT;
}
DI int n_rounds(int nblk, int NT, int MT) { return (((MT + 7) >> 3) * 8 * NT + nblk - 1) / nblk; }
DI void zero_acc(f32x4 (&acc)[4][4]) {
#pragma unroll
  for (int i = 0; i < 4; ++i)
#pragma unroll
    for (int j = 0; j < 4; ++j) acc[i][j] = (f32x4){0.f, 0.f, 0.f, 0.f};
}

DI int mapcol(int kind, int n) {
  switch (kind) {
    case 1: return n < 640 ? n : (n < 4224 ? n + 32 : (n < 4256 ? n - 4224 + 640 : -1));
    case 2: return n + 4256;
    case 3: return n < 512 ? (n >> 6) * 96 + (n & 63) : ((n - 512) >> 5) * 96 + 64 + ((n - 512) & 31);
    case 4: return n < 512 ? (n >> 6) * 128 + (n & 63) : ((n - 512) >> 6) * 128 + 64 + (n & 63);
    case 5: { const int j = n >> 7, c = n & 127, wc = c >> 6, ni = (c >> 4) & 3, x = c & 15; const int f = j * 64 + wc * 32 + (ni >> 1) * 16 + x; return (ni & 1) ? DFF + f : f; }
    default: return n;
  }
}
DI void conv_tile(const float* __restrict__ W, int ldw, const float* __restrict__ ksc, int kind, bf16_t* __restrict__ out, int ldo, int tn, int tk, char* lds) {
  float* T = (float*)lds;
  const int tid = opq((int)threadIdx.x), nn = tid & 63, kk0 = tid >> 6;
  const int src = mapcol(kind, tn * 64 + nn);
  float wv[16];
#pragma unroll
  for (int i = 0; i < 16; ++i) wv[i] = src >= 0 ? W[(size_t)(tk * 64 + kk0 + 4 * i) * ldw + src] : 0.f;
#pragma unroll
  for (int i = 0; i < 16; ++i) {
    const int k = kk0 + 4 * i;
    T[k * 65 + nn] = ksc ? wv[i] * ksc[tk * 64 + k] : wv[i];
  }
  __syncthreads();
  const int n = tid >> 2, kq = tid & 3;
  u32x4 o0, o1;
  o0.x = pk2(T[(kq * 16 + 0) * 65 + n], T[(kq * 16 + 1) * 65 + n]); o0.y = pk2(T[(kq * 16 + 2) * 65 + n], T[(kq * 16 + 3) * 65 + n]);
  o0.z = pk2(T[(kq * 16 + 4) * 65 + n], T[(kq * 16 + 5) * 65 + n]); o0.w = pk2(T[(kq * 16 + 6) * 65 + n], T[(kq * 16 + 7) * 65 + n]);
  o1.x = pk2(T[(kq * 16 + 8) * 65 + n], T[(kq * 16 + 9) * 65 + n]); o1.y = pk2(T[(kq * 16 + 10) * 65 + n], T[(kq * 16 + 11) * 65 + n]);
  o1.z = pk2(T[(kq * 16 + 12) * 65 + n], T[(kq * 16 + 13) * 65 + n]); o1.w = pk2(T[(kq * 16 + 14) * 65 + n], T[(kq * 16 + 15) * 65 + n]);
  bf16_t* op = out + (size_t)(tn * 64 + n) * ldo + tk * 64 + kq * 16;
  *(u32x4*)op = o0; *(u32x4*)(op + 8) = o1;
  __syncthreads();
}

template <int TYPE>
DI void attn_item(const bf16_t* __restrict__ Q, const bf16_t* __restrict__ Q2, int ldq, const bf16_t* __restrict__ K1, const bf16_t* __restrict__ K2,
                  const bf16_t* __restrict__ Vt, int ldv, bf16_t* __restrict__ O, int ldo, int nq, int ntiles, int wlimit, int nlast,
                  float lam, float oscale, const float* __restrict__ gn, char* lds) {
  constexpr int DK = TYPE == 0 ? 96 : 64;
  constexpr int KLD = (DK + 8) * 2;
  constexpr int KT_B = 64 * KLD;
  constexpr int VLD = 144;
  constexpr int VT_B = 64 * VLD;
  constexpr int ST_B = KT_B + VT_B;
  constexpr int NKCH = DK / 8;
  constexpr int NKL = 64 * NKCH / 256;
  constexpr int NMAP = TYPE == 0 ? 1 : 2;
  constexpr int NKS = TYPE == 0 ? 3 : 1;
  const int tid = opq((int)threadIdx.x), lane = tid & 63, wave = tid >> 6, fr = lane & 15, fq = lane >> 4;

  bf16x8 qf[NMAP][2][NKS];
#pragma unroll
  for (int qg = 0; qg < 2; ++qg) {
    int row = wave * 32 + qg * 16 + fr; row = row < nq ? row : nq - 1;
    if (TYPE == 0) {
      qf[0][qg][0] = *(const bf16x8*)(Q + (size_t)row * ldq + fq * 8);
      qf[0][qg][NKS > 1 ? 1 : 0] = *(const bf16x8*)(Q + (size_t)row * ldq + 32 + fq * 8);
      qf[0][qg][NKS - 1] = *(const bf16x8*)(Q2 + (size_t)row * ldq + fq * 8);
    } else {
      qf[0][qg][0] = *(const bf16x8*)(Q + (size_t)row * ldq + fq * 8);
      qf[NMAP - 1][qg][0] = *(const bf16x8*)(Q + (size_t)row * ldq + 32 + fq * 8);
    }
  }
  f32x4 o[NMAP][2][4];
  float mrun[NMAP][2], lrun[NMAP][2];
#pragma unroll
  for (int j = 0; j < NMAP; ++j)
#pragma unroll
    for (int qg = 0; qg < 2; ++qg) {
      mrun[j][qg] = -1e30f; lrun[j][qg] = 0.f;
#pragma unroll
      for (int dt = 0; dt < 4; ++dt) o[j][qg][dt] = (f32x4){0.f, 0.f, 0.f, 0.f};
    }

  u32x4 kr[NKL], vr[2];
#pragma unroll
  for (int i = 0; i < NKL; ++i) {
    const int c = tid + i * 256, key = c / NKCH, part = c % NKCH;
    const bf16_t* src = (TYPE == 0 && part >= 8) ? K2 + (size_t)key * 32 + (part - 8) * 8 : K1 + (size_t)key * 512 + part * 8;
    kr[i] = *(const u32x4*)src;
  }
#pragma unroll
  for (int i = 0; i < 2; ++i) { const int c = tid + i * 256, d = c >> 3, part = c & 7; vr[i] = *(const u32x4*)(Vt + (size_t)d * ldv + part * 8); }
#pragma unroll
  for (int i = 0; i < NKL; ++i) { const int c = tid + i * 256, key = c / NKCH, part = c % NKCH; *(u32x4*)(lds + key * KLD + part * 16) = kr[i]; }
#pragma unroll
  for (int i = 0; i < 2; ++i) { const int c = tid + i * 256, d = c >> 3, part = c & 7; *(u32x4*)(lds + KT_B + d * VLD + part * 16) = vr[i]; }
  __syncthreads();

  for (int kt = 0; kt < ntiles; ++kt) {
    const int cur = (kt & 1) * ST_B;
    const bool more = kt + 1 < ntiles;
    if (more) {
      const size_t k0 = (size_t)(kt + 1) * 64;
#pragma unroll
      for (int i = 0; i < NKL; ++i) {
        const int c = tid + i * 256, key = c / NKCH, part = c % NKCH;
        const bf16_t* src = (TYPE == 0 && part >= 8) ? K2 + (k0 + key) * 32 + (part - 8) * 8 : K1 + (k0 + key) * 512 + part * 8;
        kr[i] = *(const u32x4*)src;
      }
#pragma unroll
      for (int i = 0; i < 2; ++i) { const int c = tid + i * 256, d = c >> 3, part = c & 7; vr[i] = *(const u32x4*)(Vt + (size_t)d * ldv + k0 + part * 8); }
    }
    if (kt < wlimit) {
      bf16x8 pf[NMAP][2][2];
#pragma unroll
      for (int j = 0; j < NMAP; ++j) {
        f32x4 s[2][4];
#pragma unroll
        for (int qg = 0; qg < 2; ++qg)
#pragma unroll
          for (int kk = 0; kk < 4; ++kk) s[qg][kk] = (f32x4){0.f, 0.f, 0.f, 0.f};
        __builtin_amdgcn_s_setprio(1);
#pragma unroll
        for (int kk = 0; kk < 4; ++kk) {
#pragma unroll
          for (int ks = 0; ks < NKS; ++ks) {
            const bf16x8 kf = *(const bf16x8*)(lds + cur + (kk * 16 + fr) * KLD + (j * 32 + ks * 32 + fq * 8) * 2);
#pragma unroll
            for (int qg = 0; qg < 2; ++qg) s[qg][kk] = MFMA16(kf, qf[j][qg][ks], s[qg][kk]);
          }
        }
        __builtin_amdgcn_s_setprio(0);
        if (kt == ntiles - 1 && nlast < 64) {
#pragma unroll
          for (int qg = 0; qg < 2; ++qg)
#pragma unroll
            for (int kk = 0; kk < 4; ++kk) {
              const int key = kk * 16 + fq * 4;
              if (key + 0 >= nlast) s[qg][kk].x = -1e30f;
              if (key + 1 >= nlast) s[qg][kk].y = -1e30f;
              if (key + 2 >= nlast) s[qg][kk].z = -1e30f;
              if (key + 3 >= nlast) s[qg][kk].w = -1e30f;
            }
        }
#pragma unroll
        for (int qg = 0; qg < 2; ++qg) {
          float mx = -1e30f;
#pragma unroll
          for (int kk = 0; kk < 4; ++kk) mx = fmaxf(mx, fmaxf(fmaxf(s[qg][kk].x, s[qg][kk].y), fmaxf(s[qg][kk].z, s[qg][kk].w)));
          mx = quadmax(mx);
          if (!__all(mx - mrun[j][qg] <= 8.0f)) {
            const float mnew = fmaxf(mrun[j][qg], mx);
            const float al = ex2(mrun[j][qg] - mnew);
            mrun[j][qg] = mnew;
            lrun[j][qg] *= al;
#pragma unroll
            for (int dt = 0; dt < 4; ++dt) o[j][qg][dt] *= al;
          }
          const float mn = mrun[j][qg];
          float ps = 0.f;
#pragma unroll
          for (int kk = 0; kk < 4; ++kk) {
            f32x4 pp;
            pp.x = ex2(s[qg][kk].x - mn); pp.y = ex2(s[qg][kk].y - mn); pp.z = ex2(s[qg][kk].z - mn); pp.w = ex2(s[qg][kk].w - mn);
            ps += (pp.x + pp.y) + (pp.z + pp.w);
            s[qg][kk] = pp;
          }
          lrun[j][qg] += ps;
#pragma unroll
          for (int s2 = 0; s2 < 2; ++s2) {
            u32x4 w;
            w.x = pk2(s[qg][2 * s2].x, s[qg][2 * s2].y); w.y = pk2(s[qg][2 * s2].z, s[qg][2 * s2].w);
            w.z = pk2(s[qg][2 * s2 + 1].x, s[qg][2 * s2 + 1].y); w.w = pk2(s[qg][2 * s2 + 1].z, s[qg][2 * s2 + 1].w);
            pf[j][qg][s2] = __builtin_bit_cast(bf16x8, w);
          }
        }
      }
      __builtin_amdgcn_s_setprio(1);
#pragma unroll
      for (int dt = 0; dt < 4; ++dt)
#pragma unroll
        for (int s2 = 0; s2 < 2; ++s2) {
          const char* vb = lds + cur + KT_B + (dt * 16 + fr) * VLD + (32 * s2 + fq * 4) * 2;
          const u32x2 lo = *(const u32x2*)vb, hi = *(const u32x2*)(vb + 32);
          u32x4 w; w.x = lo.x; w.y = lo.y; w.z = hi.x; w.w = hi.y;
          const bf16x8 vf = __builtin_bit_cast(bf16x8, w);
#pragma unroll
          for (int j = 0; j < NMAP; ++j)
#pragma unroll
            for (int qg = 0; qg < 2; ++qg) o[j][qg][dt] = MFMA16(vf, pf[j][qg][s2], o[j][qg][dt]);
        }
      __builtin_amdgcn_s_setprio(0);
    }
    if (more) {
      const int nxt = ST_B - cur;
#pragma unroll
      for (int i = 0; i < NKL; ++i) { const int c = tid + i * 256, key = c / NKCH, part = c % NKCH; *(u32x4*)(lds + nxt + key * KLD + part * 16) = kr[i]; }
#pragma unroll
      for (int i = 0; i < 2; ++i) { const int c = tid + i * 256, d = c >> 3, part = c & 7; *(u32x4*)(lds + nxt + KT_B + d * VLD + part * 16) = vr[i]; }
    }
    __syncthreads();
  }
#pragma unroll
  for (int qg = 0; qg < 2; ++qg) {
    const int row = wave * 32 + qg * 16 + fr;
    if (TYPE == 0) {
      const float inv = 1.f / quadsum(lrun[0][qg]);
      if (row < nq) {
#pragma unroll
        for (int dt = 0; dt < 4; ++dt) *(u32x2*)(O + (size_t)row * ldo + dt * 16 + fq * 4) = pk4(o[0][qg][dt] * inv);
      }
    } else {
      const float inv0 = 1.f / quadsum(lrun[0][qg]);
      const float inv1 = lam / quadsum(lrun[NMAP - 1][qg]);
      f32x4 v[4];
      float ss = 0.f;
#pragma unroll
      for (int dt = 0; dt < 4; ++dt) { v[dt] = o[0][qg][dt] * inv0 - o[NMAP - 1][qg][dt] * inv1; ss += dot4(v[dt]); }
      ss = quadsum(ss);
      const float r = rsqrtf(ss * (1.f / 64.f) + EPS) * oscale;
      if (row < nq) {
#pragma unroll
        for (int dt = 0; dt < 4; ++dt) { const f32x4 g4 = *(const f32x4*)(gn + dt * 16 + fq * 4); *(u32x2*)(O + (size_t)row * ldo + dt * 16 + fq * 4) = pk4(v[dt] * r * g4); }
      }
    }
  }
}

DI void hgrn_unit(const bf16_t* hq, bf16_t* ob, const bf16_t* __restrict__ hf, const bf16_t* __restrict__ hi, const bf16_t* __restrict__ hg, int h, int T,
                  const float* __restrict__ S0, float* __restrict__ Sout, const float* __restrict__ lbl, int layer, const float* __restrict__ gn, char* lds) {
  constexpr int CH = 32;
  float* qL = (float*)lds;
  float* kL = qL + CH * 64;
  float* vL = kL + CH * 64;
  float* oP = vL + CH * 64;
  const int tid = opq((int)threadIdx.x), vv = tid & 63, kq = tid >> 6;
  const int lt = tid >> 3, part = tid & 7;
  f32x2 S[8];
#pragma unroll
  for (int i = 0; i < 8; ++i) { S[i].x = S0 ? S0[(size_t)(kq * 16 + 2 * i) * 64 + vv] : 0.f; S[i].y = S0 ? S0[(size_t)(kq * 16 + 2 * i + 1) * 64 + vv] : 0.f; }
  float omlb[8];
#pragma unroll
  for (int i = 0; i < 8; ++i) {
    const int kc = h * 64 + part * 8 + i;
    omlb[i] = layer == 0 ? 1.f : sigm(lbl[kc] - lbl[512 + kc]);
  }
  const f32x4 gv0 = *(const f32x4*)(gn + part * 8), gv1 = *(const f32x4*)(gn + part * 8 + 4);
  const int nch = (T + CH - 1) / CH;
  u32x4 rq, rk, rv;
  {
    const int t = lt < T ? lt : T - 1;
    const size_t off = (size_t)t * 512 + h * 64 + part * 8;
    rq = *(const u32x4*)(hq + off); rk = *(const u32x4*)(hf + off); rv = *(const u32x4*)(hi + off);
  }
  for (int c = 0; c < nch; ++c) {
    {
      const int e = lt * 64 + part * 8;
      qL[e + 0] = __uint_as_float(rq.x << 16); qL[e + 1] = __uint_as_float(rq.x & 0xffff0000u);
      qL[e + 2] = __uint_as_float(rq.y << 16); qL[e + 3] = __uint_as_float(rq.y & 0xffff0000u);
      qL[e + 4] = __uint_as_float(rq.z << 16); qL[e + 5] = __uint_as_float(rq.z & 0xffff0000u);
      qL[e + 6] = __uint_as_float(rq.w << 16); qL[e + 7] = __uint_as_float(rq.w & 0xffff0000u);
      vL[e + 0] = __uint_as_float(rv.x << 16); vL[e + 1] = __uint_as_float(rv.x & 0xffff0000u);
      vL[e + 2] = __uint_as_float(rv.y << 16); vL[e + 3] = __uint_as_float(rv.y & 0xffff0000u);
      vL[e + 4] = __uint_as_float(rv.z << 16); vL[e + 5] = __uint_as_float(rv.z & 0xffff0000u);
      vL[e + 6] = __uint_as_float(rv.w << 16); vL[e + 7] = __uint_as_float(rv.w & 0xffff0000u);
      kL[e + 0] = omlb[0] * sigm(-__uint_as_float(rk.x << 16)); kL[e + 1] = omlb[1] * sigm(-__uint_as_float(rk.x & 0xffff0000u));
      kL[e + 2] = omlb[2] * sigm(-__uint_as_float(rk.y << 16)); kL[e + 3] = omlb[3] * sigm(-__uint_as_float(rk.y & 0xffff0000u));
      kL[e + 4] = omlb[4] * sigm(-__uint_as_float(rk.z << 16)); kL[e + 5] = omlb[5] * sigm(-__uint_as_float(rk.z & 0xffff0000u));
      kL[e + 6] = omlb[6] * sigm(-__uint_as_float(rk.w << 16)); kL[e + 7] = omlb[7] * sigm(-__uint_as_float(rk.w & 0xffff0000u));
    }
    __syncthreads();
    if (c + 1 < nch) {
      int t = (c + 1) * CH + lt; t = t < T ? t : T - 1;
      const size_t off = (size_t)t * 512 + h * 64 + part * 8;
      rq = *(const u32x4*)(hq + off); rk = *(const u32x4*)(hf + off); rv = *(const u32x4*)(hi + off);
    }
    const int nt = (T - c * CH) < CH ? (T - c * CH) : CH;
    for (int t = 0; t < nt; ++t) {
      const float vt = vL[t * 64 + vv];
      const f32x2 vt2 = {vt, vt};
      f32x2 o2 = {0.f, 0.f};
#pragma unroll
      for (int i4 = 0; i4 < 4; ++i4) {
        const f32x4 k4 = *(const f32x4*)(kL + t * 64 + kq * 16 + i4 * 4);
        const f32x4 q4 = *(const f32x4*)(qL + t * 64 + kq * 16 + i4 * 4);
        const f32x2 ka = {k4.x, k4.y}, kb = {k4.z, k4.w}, qa = {q4.x, q4.y}, qb2 = {q4.z, q4.w};
        S[i4 * 2 + 0] = __builtin_elementwise_fma(ka, vt2 - S[i4 * 2 + 0], S[i4 * 2 + 0]); o2 = __builtin_elementwise_fma(qa, S[i4 * 2 + 0], o2);
        S[i4 * 2 + 1] = __builtin_elementwise_fma(kb, vt2 - S[i4 * 2 + 1], S[i4 * 2 + 1]); o2 = __builtin_elementwise_fma(qb2, S[i4 * 2 + 1], o2);
      }
      const float oacc = o2.x + o2.y;
      oP[(kq * CH + t) * 64 + vv] = oacc;
    }
    __syncthreads();
    {
      const int t = c * CH + lt;
      f32x4 a0 = *(const f32x4*)(oP + (0 * CH + lt) * 64 + part * 8), a1 = *(const f32x4*)(oP + (0 * CH + lt) * 64 + part * 8 + 4);
#pragma unroll
      for (int w = 1; w < 4; ++w) { a0 += *(const f32x4*)(oP + (w * CH + lt) * 64 + part * 8); a1 += *(const f32x4*)(oP + (w * CH + lt) * 64 + part * 8 + 4); }
      float ss = dot4(a0) + dot4(a1);
      ss += __shfl_xor(ss, 1); ss += __shfl_xor(ss, 2); ss += __shfl_xor(ss, 4);
      const float r = rsqrtf(ss * (1.f / 64.f) + EPS);
      if (t < T) {
        const size_t off = (size_t)t * 512 + h * 64 + part * 8;
        const u32x4 g = *(const u32x4*)(hg + off);
        u32x4 w;
        w.x = pk2(a0.x * r * gv0.x * __uint_as_float(g.x << 16), a0.y * r * gv0.y * __uint_as_float(g.x & 0xffff0000u));
        w.y = pk2(a0.z * r * gv0.z * __uint_as_float(g.y << 16), a0.w * r * gv0.w * __uint_as_float(g.y & 0xffff0000u));
        w.z = pk2(a1.x * r * gv1.x * __uint_as_float(g.z << 16), a1.y * r * gv1.y * __uint_as_float(g.z & 0xffff0000u));
        w.w = pk2(a1.z * r * gv1.z * __uint_as_float(g.w << 16), a1.w * r * gv1.w * __uint_as_float(g.w & 0xffff0000u));
        *(u32x4*)(ob + off) = w;
      }
    }
    __syncthreads();
  }
#pragma unroll
  for (int i = 0; i < 8; ++i) { Sout[(size_t)(kq * 16 + 2 * i) * 64 + vv] = S[i].x; Sout[(size_t)(kq * 16 + 2 * i + 1) * 64 + vv] = S[i].y; }
}


#define XB_TMO      128
#define XB_XCNT(j)  (256  + 64 * (j))
#define XB_XSUB(j)  (1280 + 64 * (j))
#define XB_XGEN(j)  (2304 + 64 * (j))
#define XB_TOP      3328
#define XB_TOPGEN   3392
#define XCD_BAR_WORDS 3456
#define XB_SPIN_CAP (1u << 18)
#define LAS __attribute__((address_space(3)))
DI unsigned xb_ld(unsigned* p)              { return __hip_atomic_load(p, __ATOMIC_RELAXED, __HIP_MEMORY_SCOPE_AGENT); }
DI unsigned xb_add(unsigned* p, unsigned v) { return __hip_atomic_fetch_add(p, v, __ATOMIC_RELAXED, __HIP_MEMORY_SCOPE_AGENT); }
DI unsigned xb_xcc_id() { return (unsigned)__builtin_amdgcn_s_getreg((3 << 11) | 20) & 0xFu; }
#define XB_SPIN(cond, bar) do { unsigned _sp = 0; while (cond) { __builtin_amdgcn_s_sleep(1); \
    if ((++_sp & 255u) == 0u) { if (xb_ld(&(bar)[XB_TMO])) break; if (_sp > XB_SPIN_CAP) { atomicAdd(&(bar)[XB_TMO], 1u); break; } } } } while (0)
struct XcdBarrier { unsigned* bar; unsigned x; volatile LAS unsigned* st; };
DI XcdBarrier xcd_barrier_post(unsigned* bar, volatile LAS unsigned* st) {
    XcdBarrier b; b.bar = bar; b.x = xb_xcc_id(); b.st = st;
    if (threadIdx.x == 0) (void)xb_add(&bar[XB_XCNT(b.x)], 1u);
    return b;
}
DI void xcd_barrier_complete(unsigned* bar, unsigned x, unsigned& nloc, unsigned& nx) {
    const unsigned G = gridDim.x * gridDim.y * gridDim.z;
    unsigned sum, cnt, mine, sp = 0u;
    for (;;) {
        sum = 0u; cnt = 0u; mine = 0u;
#pragma unroll
        for (unsigned j = 0; j < 16; ++j) { const unsigned c = xb_ld(&bar[XB_XCNT(j)]); sum += c; cnt += (c > 0u) ? 1u : 0u; mine = (j == x) ? c : mine; }
        if (sum == G) break;
        __builtin_amdgcn_s_sleep(1);
        if ((++sp & 255u) == 0u) { if (xb_ld(&bar[XB_TMO])) break; if (sp > XB_SPIN_CAP) { atomicAdd(&bar[XB_TMO], 1u); break; } }
    }
    nloc = mine > 0u ? mine : 1u; nx = cnt > 0u ? cnt : 1u;
}
DI void xcd_barrier(const XcdBarrier& b) {
    asm volatile("s_waitcnt vmcnt(0)" ::: "memory");
    __syncthreads();
    if (threadIdx.x == 0) {
        unsigned* bar = b.bar;
        __builtin_amdgcn_s_waitcnt(0);
        unsigned nloc = b.st[0], nx = b.st[1];
        if (nloc == 0u) { xcd_barrier_complete(bar, b.x, nloc, nx); b.st[0] = nloc; b.st[1] = nx; }
        const unsigned old = xb_add(&bar[XB_XSUB(b.x)], 1u);
        const unsigned gen = old / nloc;
        if (old + 1u == (gen + 1u) * nloc) {
            __builtin_amdgcn_fence(__ATOMIC_RELEASE, "agent");
            asm volatile("s_waitcnt vmcnt(0)" ::: "memory");
            const unsigned og = xb_add(&bar[XB_TOP], 1u);
            const unsigned tg = og / nx;
            if (og + 1u == (tg + 1u) * nx) xb_add(&bar[XB_TOPGEN], 1u);
            else XB_SPIN(xb_ld(&bar[XB_TOPGEN]) == tg, bar);
            __builtin_amdgcn_fence(__ATOMIC_ACQUIRE, "agent");
            xb_add(&bar[XB_XGEN(b.x)], 1u);
            asm volatile("s_waitcnt vmcnt(0)" ::: "memory");
        } else {
            XB_SPIN(xb_ld(&bar[XB_XGEN(b.x)]) == gen, bar);
            __builtin_amdgcn_fence(__ATOMIC_ACQUIRE, "agent");
            asm volatile("s_waitcnt vmcnt(0)" ::: "memory");
        }
    }
    __syncthreads();
}

__global__ void __launch_bounds__(256, 2) fwd_megakernel(Params p) {
  cg::grid_group grid = cg::this_grid();
  __shared__ __attribute__((aligned(16))) char lds[LDS_BYTES];
  __shared__ int s_item;
  __shared__ uint4 xb_words;
  const int tid = opq((int)threadIdx.x), lane = tid & 63, wave = tid >> 6, wr = wave >> 1, wc = wave & 1, fr = lane & 15, fq = lane >> 4;
  const int nblk = gridDim.x, bid = blockIdx.x;
  Layout L; make_layout(p.ng, L);
  char* ws = p.ws;
  float* out = p.out;
  const int ng = p.ng, SPG = 32 / ng, TG = SPG * 2048, R = TG + 128, MTP = TG / 128;
  bf16_t* w_in = (bf16_t*)(ws + L.w_in); bf16_t* w_g = (bf16_t*)(ws + L.w_g); bf16_t* w_uq = (bf16_t*)(ws + L.w_uq);
  bf16_t* w_ukvG = (bf16_t*)(ws + L.w_ukvG); bf16_t* w_ukvP = (bf16_t*)(ws + L.w_ukvP); bf16_t* w_br = (bf16_t*)(ws + L.w_br);
  bf16_t* w_out = (bf16_t*)(ws + L.w_out); bf16_t* w_up = (bf16_t*)(ws + L.w_up); bf16_t* w_down = (bf16_t*)(ws + L.w_down);
  f32x2* rope = (f32x2*)(ws + L.rope); int* ctr = (int*)(ws + L.ctr);
  bf16_t* xb = (bf16_t*)(ws + L.xb); float* ssq0 = (float*)(ws + L.ssq0); float* ssq1 = (float*)(ws + L.ssq1);
  float* ssqq = (float*)(ws + L.ssqq); float* ssqkv = (float*)(ws + L.ssqkv);
  bf16_t* qlat = (bf16_t*)(ws + L.qlat); bf16_t* qb = (bf16_t*)(ws + L.q); bf16_t* kvlat = (bf16_t*)(ws + L.kvlat); bf16_t* krot = (bf16_t*)(ws + L.krot);
  bf16_t* knope = (bf16_t*)(ws + L.kv); bf16_t* vtM = knope + (size_t)R * 512; bf16_t* mbuf = (bf16_t*)(ws + L.kv);
  bf16_t* hq = (bf16_t*)(ws + L.hq); bf16_t* hf = (bf16_t*)(ws + L.hf); bf16_t* hi = (bf16_t*)(ws + L.hi); bf16_t* hg = (bf16_t*)(ws + L.hg);
  bf16_t* dq = (bf16_t*)(ws + L.dq); bf16_t* dk = (bf16_t*)(ws + L.dk); bf16_t* dvT = (bf16_t*)(ws + L.dvT); bf16_t* hmid = (bf16_t*)(ws + L.hq);
  bf16_t* ckvS = (bf16_t*)(ws + L.ckvS); bf16_t* knopeS = (bf16_t*)(ws + L.knopeS); bf16_t* vtMS = (bf16_t*)(ws + L.vtMS); bf16_t* krotS = (bf16_t*)(ws + L.krotS);
  bf16_t* dKS = (bf16_t*)(ws + L.dKS); bf16_t* dVtS = (bf16_t*)(ws + L.dVtS);
  char* gst = ws + L.gst + (size_t)bid * 131072;
  if (threadIdx.x == 0) xb_words = make_uint4(0u, 0u, 0u, 0u);
  __syncthreads();
  const XcdBarrier xbar = xcd_barrier_post((unsigned*)(ws + L.bar), (volatile LAS unsigned*)&xb_words);

  grid.sync();
  for (int l = 0; l < 2; ++l) {
    {
      if (PH & 1) {
      LANEVARS
      const int total2 = 68 * 16 + 48 * 16 + 12 * 6 + 16 * 4 + 16 * 4 + 3 * 16 * 8 + 16 * 16 + 88 * 16 + 16 * 44 + 8 * 8 * 32;
      for (int it = bid; it < total2; it += nblk) {
        int rem = it, job = 0;
        if (job == 0 && rem >= 68 * 16) { rem -= 68 * 16; job = 1; }
        if (job == 1 && rem >= 48 * 16) { rem -= 48 * 16; job = 2; }
        if (job == 2 && rem >= 12 * 6) { rem -= 12 * 6; job = 3; }
        if (job == 3 && rem >= 16 * 4) { rem -= 16 * 4; job = 4; }
        if (job == 4 && rem >= 16 * 4) { rem -= 16 * 4; job = 5; }
        if (job == 5 && rem >= 16 * 8) { rem -= 16 * 8; job = 6; }
        if (job == 6 && rem >= 16 * 8) { rem -= 16 * 8; job = 7; }
        if (job == 7 && rem >= 16 * 8) { rem -= 16 * 8; job = 8; }
        if (job == 8 && rem >= 16 * 16) { rem -= 16 * 16; job = 9; }
        if (job == 9 && rem >= 88 * 16) { rem -= 88 * 16; job = 10; }
        if (job == 10 && rem >= 16 * 44) { rem -= 16 * 44; job = 11; }
        const float* W; int ldw, kind, ldo, nkt; const float* ksc = nullptr; bf16_t* o;
        switch (job) {
          case 0: W = p.in[9] + (size_t)l * 1024 * 7328; ldw = 7328; ksc = p.in[8] + l * 1024; kind = 1; o = w_in; ldo = 1024; nkt = 16; break;
          case 1: W = p.in[9] + (size_t)l * 1024 * 7328; ldw = 7328; ksc = p.in[8] + l * 1024; kind = 2; o = w_g; ldo = 1024; nkt = 16; break;
          case 2: W = p.in[11] + (size_t)l * 384 * 768; ldw = 768; ksc = p.in[10] + l * 384; kind = 3; o = w_uq; ldo = 384; nkt = 6; break;
          case 3: W = p.in[13] + (size_t)l * 256 * 1024; ldw = 1024; ksc = p.in[12] + l * 256; kind = 4; o = w_ukvG; ldo = 256; nkt = 4; break;
          case 4: W = p.in[13] + (size_t)l * 256 * 1024; ldw = 1024; kind = 4; o = w_ukvP; ldo = 256; nkt = 4; break;
          case 5: W = p.in[18] + (size_t)(l * 3 + 0) * 512 * 1024; ldw = 1024; kind = 0; o = w_br; ldo = 512; nkt = 8; break;
          case 6: W = p.in[18] + (size_t)(l * 3 + 1) * 512 * 1024; ldw = 1024; kind = 0; o = w_br + (size_t)1024 * 512; ldo = 512; nkt = 8; break;
          case 7: W = p.in[18] + (size_t)(l * 3 + 2) * 512 * 1024; ldw = 1024; kind = 0; o = w_br + (size_t)2 * 1024 * 512; ldo = 512; nkt = 8; break;
          case 8: W = p.in[19] + (size_t)l * 1024 * 1024; ldw = 1024; kind = 0; o = w_out; ldo = 1024; nkt = 16; break;
          case 9: W = p.in[21] + (size_t)l * 1024 * 5632; ldw = 5632; ksc = p.in[20] + l * 1024; kind = 5; o = w_up; ldo = 1024; nkt = 16; break;
          case 10: W = p.in[24] + (size_t)l * 2816 * 1024; ldw = 1024; kind = 0; o = w_down; ldo = 2816; nkt = 44; break;
          default: { const int sb = rem >> 8; rem &= 255; W = p.in[5] + ((size_t)(l * 8 + sb) * 2048) * 512; ldw = 512; kind = 0; o = dVtS + (size_t)sb * 512 * KS_LD; ldo = KS_LD; nkt = 32; } break;
        }
        conv_tile(W, ldw, ksc, kind, o, ldo, rem / nkt, rem % nkt, lds);
      }
      const size_t gth = (size_t)bid * 256 + tid, gstride = (size_t)nblk * 256;
#pragma unroll 4
      for (size_t i = gth; i < (size_t)16384 * 256 / 8; i += gstride) {
        const float* s = p.in[2] + (size_t)l * 16384 * 256 + i * 8;
        const f32x4 a = *(const f32x4*)s, b = *(const f32x4*)(s + 4);
        u32x4 w; w.x = pk2(a.x, a.y); w.y = pk2(a.z, a.w); w.z = pk2(b.x, b.y); w.w = pk2(b.z, b.w);
        *(u32x4*)(ckvS + i * 8) = w;
      }
#pragma unroll 4
      for (size_t i = gth; i < (size_t)16384 * 512 / 8; i += gstride) {
        const size_t row = i >> 6, c8 = i & 63, sb = row >> 11, pos = row & 2047;
        const float* s = p.in[4] + ((size_t)l * 16384 + row) * 512 + c8 * 8;
        const f32x4 a = *(const f32x4*)s, b = *(const f32x4*)(s + 4);
        u32x4 w; w.x = pk2(a.x, a.y); w.y = pk2(a.z, a.w); w.z = pk2(b.x, b.y); w.w = pk2(b.z, b.w);
        *(u32x4*)(dKS + (sb * KS_LD + pos) * 512 + c8 * 8) = w;
      }
      for (size_t i = gth; i < (size_t)16384 * 32 / 8; i += gstride) {
        const size_t row = i >> 2, c8 = i & 3, sb = row >> 11, pos = row & 2047;
        const float* s = p.in[3] + ((size_t)l * 16384 + row) * 32 + c8 * 8;
        const f32x4 a = *(const f32x4*)s, b = *(const f32x4*)(s + 4);
        u32x4 w; w.x = pk2(a.x, a.y); w.y = pk2(a.z, a.w); w.z = pk2(b.x, b.y); w.w = pk2(b.z, b.w);
        *(u32x4*)(krotS + (sb * KS_LD + pos) * 32 + c8 * 8) = w;
      }
      for (size_t i = gth; i < (size_t)4096 * 6; i += gstride) {
        const size_t row = i / 6, c8 = i % 6;
        const u32x4 z = {0u, 0u, 0u, 0u};
        *(u32x4*)(dVtS + row * KS_LD + 2064 + c8 * 8) = z;
        *(u32x4*)(vtMS + row * KS_LD + 2064 + c8 * 8) = z;
      }
      if (l == 0) {
        if (bid == 0 && tid < 64) ctr[tid] = 0;
        for (size_t i = gth; i < (size_t)2064 * 16; i += gstride) {
          const int pos = (int)(i >> 4), k = (int)(i & 15);
          const float inv = powf(10000.f, -(float)k / 16.f);
          const float ang = (float)pos * inv;
          f32x2 cs; cs.x = cosf(ang); cs.y = sinf(ang);
          rope[i] = cs;
        }
        for (int row0 = bid * 4; row0 < NPTOK + NSTOK; row0 += nblk * 4) {
          f32x4 v[4];
#pragma unroll
          for (int r = 0; r < 4; ++r) {
            const int row = row0 + r;
            const float* s = row < NPTOK ? p.in[0] + (size_t)row * 1024 : p.in[1] + (size_t)(row - NPTOK) * 1024;
            v[r] = *(const f32x4*)(s + tid * 4);
          }
#pragma unroll
          for (int r = 0; r < 4; ++r) {
            const int row = row0 + r;
            *(u32x2*)(xb + (size_t)row * 1024 + tid * 4) = pk4(v[r]);
            float ss = dot4(v[r]);
            ss += __shfl_xor(ss, 1); ss += __shfl_xor(ss, 2); ss += __shfl_xor(ss, 4); ss += __shfl_xor(ss, 8);
            if ((tid & 15) == 0) ssq0[(size_t)row * 16 + (tid >> 4)] = ss;
          }
        }
      }
      }
    }
    xcd_barrier(xbar);

    const float lam_init = l == 0 ? 0.2f : (0.8f - 0.6f * 0.7408182206817179f);
    const float* resP = l == 0 ? p.in[0] : out + O_YP;
    const float* resS = l == 0 ? p.in[1] : out + O_YS;

    for (int g = 0; g < ng; ++g) {
      const int MT = MTP + (g == 0 ? 1 : 0);
      if (PH & 2) {
        const int MT2 = (MT + 1) >> 1;
        for (int it = 0; it < n_rounds(nblk, 34, MT2); ++it) {
        LANEVARS
        int pm, nt; if (!map_tile(it, bid, nblk, 34, MT2, pm, nt)) continue;
        const int mt0 = 2 * pm, mt1 = 2 * pm + 1;
        const bool two = mt1 < MT;
        const int xr0 = mt0 >= MTP ? NPTOK : g * TG + mt0 * 128;
        const int xr1 = !two ? xr0 : (mt1 >= MTP ? NPTOK : g * TG + mt1 * 128);
        f32x4 accA[4][4], accB[4][4]; zero_acc(accA); zero_acc(accB);
        gemm_pair(xb + (size_t)xr0 * 1024, xb + (size_t)xr1 * 1024, 1024, w_in + (size_t)nt * 128 * 1024, 1024, 1024, accA, accB, lds);
        auto epi = [&](const int mt, f32x4 (&acc)[4][4]) {
        const bool smp = mt >= MTP;
        int seg, segt;
        if (nt < 3) { seg = 0; segt = nt; } else if (nt < 5) { seg = 1; segt = nt - 3; } else if (nt < 33) { seg = 2 + ((nt - 5) >> 2); segt = (nt - 5) & 3; } else { seg = 9; segt = 0; }
#pragma unroll
        for (int mi = 0; mi < 4; ++mi) {
          const int rl = mt * 128 + wr * 64 + mi * 16 + fr;
          const int s = rl - TG;
          const int xrow = smp ? NPTOK + s : g * TG + rl;
          const float rs = rowscale16(ssq0, xrow);
          float ss = 0.f;
#pragma unroll
          for (int ni = 0; ni < 4; ++ni) {
            const int cc = segt * 128 + wc * 64 + ni * 16 + fq * 4;
            f32x4 v = acc[mi][ni] * rs;
            if (seg == 0) { *(u32x2*)(qlat + (size_t)rl * 384 + cc) = pk4(v); ss += dot4(v); }
            else if (seg == 1) {
              float* fo = smp ? out + O_SCKV + (size_t)(l * NSTOK + s) * 256 + cc : out + O_PCKV + ((size_t)l * NPTOK + xrow) * 256 + cc;
              *(f32x4*)fo = v;
              *(u32x2*)(kvlat + (size_t)rl * 256 + cc) = pk4(v); ss += dot4(v);
            } else if (seg == 2) { v.x = silu(v.x); v.y = silu(v.y); v.z = silu(v.z); v.w = silu(v.w); *(u32x2*)(hq + (size_t)rl * 512 + cc) = pk4(v); }
            else if (seg == 3) { *(u32x2*)(hf + (size_t)rl * 512 + cc) = pk4(v); }
            else if (seg == 4) { *(u32x2*)(hi + (size_t)rl * 512 + cc) = pk4(v); }
            else if (seg == 5) { v.x = silu(v.x); v.y = silu(v.y); v.z = silu(v.z); v.w = silu(v.w); *(u32x2*)(hg + (size_t)rl * 512 + cc) = pk4(v); }
            else if (seg == 6) { *(u32x2*)(dq + (size_t)rl * 512 + cc) = pk4(v * QS_DF); }
            else if (seg == 7) {
              float* fo = smp ? out + O_SDK + (size_t)(l * NSTOK + s) * 512 + cc : out + O_PDK + ((size_t)l * NPTOK + xrow) * 512 + cc;
              *(f32x4*)fo = v;
              bf16_t* bo = smp ? dKS + ((size_t)(s >> 4) * KS_LD + 2048 + (s & 15)) * 512 + cc : dk + (size_t)rl * 512 + cc;
              *(u32x2*)bo = pk4(v);
            } else if (seg == 8) {
              float* fo = smp ? out + O_SDV + (size_t)(l * NSTOK + s) * 512 + cc : out + O_PDV + ((size_t)l * NPTOK + xrow) * 512 + cc;
              *(f32x4*)fo = v;
              const int hh = cc >> 6, d = cc & 63;
              bf16_t* bo; size_t ld;
              if (smp) { bo = dVtS + ((size_t)((s >> 4) * 8 + hh) * 64 + d) * KS_LD + 2048 + (s & 15); ld = KS_LD; }
              else { bo = dvT + ((size_t)((rl >> 11) * 8 + hh) * 64 + d) * 2048 + (rl & 2047); ld = 2048; }
              const u32x2 w = pk4(v);
              bo[0] = (bf16_t)(w.x & 0xffff); bo[ld] = (bf16_t)(w.x >> 16); bo[2 * ld] = (bf16_t)(w.y & 0xffff); bo[3 * ld] = (bf16_t)(w.y >> 16);
            } else {
              if (cc < 32) {
                float* fo = smp ? out + O_SKR + (size_t)(l * NSTOK + s) * 32 + cc : out + O_PKR + ((size_t)l * NPTOK + xrow) * 32 + cc;
                *(f32x4*)fo = v;
              }
            }
          }
          if (seg <= 1) {
            ss = quadsum(ss);
            if (fq == 0) { if (seg == 0) ssqq[(size_t)rl * 8 + segt * 2 + wc] = ss; else ssqkv[(size_t)rl * 4 + segt * 2 + wc] = ss; }
          }
        }
        };
        epi(mt0, accA);
        if (two) epi(mt1, accB);
        }
      }
      xcd_barrier(xbar);

      if (PH & 4) for (int row = bid * 4 + opq((int)(threadIdx.x >> 6)); row < (g == 0 ? R : TG); row += nblk * 4) {
        LANEVARS
        const bool smp = row >= TG;
        const int s = row - TG;
        const size_t gt = (size_t)g * TG + row;
        float* ck = smp ? out + O_SCKV + (size_t)(l * NSTOK + s) * 256 : out + O_PCKV + ((size_t)l * NPTOK + gt) * 256;
        const float r = rowscale_kv(ssqkv, row);
        const f32x4 v = *(const f32x4*)(ck + lane * 4), g4 = *(const f32x4*)(p.in[12] + l * 256 + lane * 4);
        *(f32x4*)(ck + lane * 4) = v * r * g4;
        if (lane < 16) {
          float* kr = smp ? out + O_SKR + (size_t)(l * NSTOK + s) * 32 : out + O_PKR + ((size_t)l * NPTOK + gt) * 32;
          const int pos = smp ? 2048 + (s & 15) : (row & 2047);
          const float x1 = kr[lane], x2 = kr[lane + 16];
          const f32x2 cs = rope[pos * 16 + lane];
          const float o1 = x1 * cs.x - x2 * cs.y, o2 = x2 * cs.x + x1 * cs.y;
          kr[lane] = o1; kr[lane + 16] = o2;
          bf16_t* kb = smp ? krotS + ((size_t)(s >> 4) * KS_LD + 2048 + (s & 15)) * 32 : krot + (size_t)row * 32;
          kb[lane] = (bf16_t)(pk2(o1, 0.f) & 0xffff); kb[lane + 16] = (bf16_t)(pk2(o2, 0.f) & 0xffff);
        }
      }
      if (PH & 4) for (int it = 0; it < n_rounds(nblk, 6, MT); ++it) {
        LANEVARS
        int mt, nt; if (!map_tile(it, bid, nblk, 6, MT, mt, nt)) continue;
        const bool smp = mt >= MTP;
        f32x4 acc[4][4]; zero_acc(acc);
        gemm_tile<false>(qlat + (size_t)mt * 128 * 384, 384, w_uq + (size_t)nt * 128 * 384, 384, 384, acc, lds);
#pragma unroll
        for (int mi = 0; mi < 4; ++mi) {
          const int rl = mt * 128 + wr * 64 + mi * 16 + fr;
          const f32x4 a = *(const f32x4*)(ssqq + (size_t)rl * 8); const f32x2 b = *(const f32x2*)(ssqq + (size_t)rl * 8 + 4);
          const float rq = rsqrtf((((a.x + a.y) + (a.z + a.w)) + (b.x + b.y)) * (1.f / 384.f) + EPS) * QS_MLA;
          bf16_t* qrow = qb + (size_t)rl * 768 + nt * 128 + wc * 64 + fq * 4;
          if (nt < 4) {
#pragma unroll
            for (int ni = 0; ni < 4; ++ni) *(u32x2*)(qrow + ni * 16) = pk4(acc[mi][ni] * rq);
          } else {
            const int pos = smp ? 2048 + ((rl - TG) & 15) : (rl & 2047);
            const f32x4 c01 = *(const f32x4*)(rope + pos * 16 + fq * 4), c23 = *(const f32x4*)(rope + pos * 16 + fq * 4 + 2);
            const f32x4 cs = {c01.x, c01.z, c23.x, c23.z}, sn = {c01.y, c01.w, c23.y, c23.w};
#pragma unroll
            for (int np = 0; np < 2; ++np) {
              const f32x4 lo = acc[mi][2 * np] * rq, hi2 = acc[mi][2 * np + 1] * rq;
              *(u32x2*)(qrow + (2 * np) * 16) = pk4(lo * cs - hi2 * sn);
              *(u32x2*)(qrow + (2 * np + 1) * 16) = pk4(hi2 * cs + lo * sn);
            }
          }
        }
      }
      if (PH & 8) {
        const int MTK = MT + (g == 0 ? 128 : 0);
        for (int it = 0; it < n_rounds(nblk, 8, MTK); ++it) {
          LANEVARS
          int mt, nt; if (!map_tile(it, bid, nblk, 8, MTK, mt, nt)) continue;
          const bool past = mt >= MT;
          const bool smp = !past && mt >= MTP;
          const int pm = mt - MT;
          const bf16_t* A = past ? ckvS + (size_t)pm * 128 * 256 : kvlat + (size_t)mt * 128 * 256;
          const bf16_t* W = (past ? w_ukvP : w_ukvG) + (size_t)nt * 128 * 256;
          f32x4 acc[4][4]; zero_acc(acc);
          if (nt < 4) {
            gemm_tile<false>(A, 256, W, 256, 256, acc, lds);
#pragma unroll
            for (int mi = 0; mi < 4; ++mi) {
              const int rt = wr * 64 + mi * 16 + fr;
              const int rl = mt * 128 + rt;
              const float r = past ? 1.f : rowscale_kv(ssqkv, rl);
              bf16_t* dst;
              if (past) dst = knopeS + ((size_t)(pm >> 4) * KS_LD + (pm & 15) * 128 + rt) * 512;
              else if (smp) dst = knopeS + ((size_t)(rt >> 4) * KS_LD + 2048 + (rt & 15)) * 512;
              else dst = knope + (size_t)rl * 512;
              dst += nt * 128 + wc * 64 + fq * 4;
#pragma unroll
              for (int ni = 0; ni < 4; ++ni) *(u32x2*)(dst + ni * 16) = pk4(acc[mi][ni] * r);
            }
          } else {
            gemm_tile<true>(A, 256, W, 256, 256, acc, lds);
#pragma unroll
            for (int mi = 0; mi < 4; ++mi) {
              const int rt = wr * 64 + mi * 16 + fq * 4;
              const int rl = mt * 128 + rt;
              f32x4 r4 = {1.f, 1.f, 1.f, 1.f};
              if (!past) { r4.x = rowscale_kv(ssqkv, rl); r4.y = rowscale_kv(ssqkv, rl + 1); r4.z = rowscale_kv(ssqkv, rl + 2); r4.w = rowscale_kv(ssqkv, rl + 3); }
#pragma unroll
              for (int ni = 0; ni < 4; ++ni) {
                const int n = (nt - 4) * 128 + wc * 64 + ni * 16 + fr;
                bf16_t* dst;
                if (past) dst = vtMS + ((size_t)(pm >> 4) * 512 + n) * KS_LD + (pm & 15) * 128 + rt;
                else if (smp) dst = vtMS + ((size_t)(rt >> 4) * 512 + n) * KS_LD + 2048 + (rt & 15);
                else dst = vtM + ((size_t)(rl >> 11) * 512 + n) * 2048 + (rl & 2047);
                *(u32x2*)dst = pk4(acc[mi][ni] * r4);
              }
            }
          }
        }
      }
      xcd_barrier(xbar);

      if (PH & 16) {
        LANEVARS
        const int n_hg = SPG * 8 + (g == 0 ? 64 : 0);
        const int n_sa = g == 0 ? 128 : 0;
        const int n_items = n_hg + n_sa + 16 * SPG * 16;
        int* my_ctr = ctr + l * 8 + g;
        float lam = 0.f;
        {
          const float* dl = p.in[16] + l * 128;
          float s1 = 0.f, s2 = 0.f;
          for (int i = 0; i < 32; ++i) { s1 += dl[i] * dl[32 + i]; s2 += dl[64 + i] * dl[96 + i]; }
          lam = __expf(s1) - __expf(s2) + lam_init;
        }
        for (int pass = DRY4 ? 0 : 1; pass < 2; ++pass) {
        const bool dry = pass == 0;
        bf16_t* dryb = (bf16_t*)(ws + L.total);
        if (dry) my_ctr += 32; else if (DRY4) my_ctr -= 32;
        for (;;) {
          if (tid == 0) s_item = atomicAdd(my_ctr, 1);
          __syncthreads();
          int it = s_item;
          __syncthreads();
          if (it >= n_items) break;
          if (it < n_hg) {
            if (it < SPG * 8) {
              const int lb = it >> 3, h = it & 7, b = g * SPG + lb;
              const size_t ro = (size_t)lb * 2048 * 512;
              hgrn_unit(hq + ro, (dry ? dryb : hq) + ro, hf + ro, hi + ro, hg + ro, h, 2048, nullptr, dry ? (float*)dryb : out + O_PHG + ((size_t)(l * 32 + b) * 8 + h) * 4096, p.in[14], l, p.in[15] + l * 64, lds);
            } else {
              const int u = it - SPG * 8, sb = u >> 3, h = u & 7;
              const size_t ro = (size_t)(TG + sb * 16) * 512;
              hgrn_unit(hq + ro, (dry ? dryb : hq) + ro, hf + ro, hi + ro, hg + ro, h, 16, p.in[6] + ((size_t)(l * 8 + sb) * 8 + h) * 4096, dry ? (float*)dryb : out + O_SHG + ((size_t)(l * 8 + sb) * 8 + h) * 4096, p.in[14], l, p.in[15] + l * 64, lds);
            }
            continue;
          }
          it -= n_hg;
          if (it < n_sa) {
            const int type = it & 1, h = (it >> 1) & 7, sb = it >> 4;
            const size_t r0 = (size_t)TG + sb * 16;
            const int wl = wave == 0 ? 33 : 0;
            if (type == 0)
              attn_item<0>(qb + r0 * 768 + h * 64, qb + r0 * 768 + 512 + h * 32, 768, knopeS + (size_t)sb * KS_LD * 512 + h * 64, krotS + (size_t)sb * KS_LD * 32,
                           vtMS + (size_t)(sb * 8 + h) * 64 * KS_LD, KS_LD, (dry ? dryb : qb) + r0 * 768 + h * 64, 768, 16, 33, wl, 16, 0.f, 1.f, nullptr, lds);
            else
              attn_item<1>(dq + r0 * 512 + h * 64, nullptr, 512, dKS + (size_t)sb * KS_LD * 512 + h * 64, nullptr,
                           dVtS + (size_t)(sb * 8 + h) * 64 * KS_LD, KS_LD, (dry ? dryb : dq) + r0 * 512 + h * 64, 512, 16, 33, wl, 16, lam, 1.f - lam_init, p.in[17] + l * 64, lds);
            continue;
          }
          it -= n_sa;
          {
            const int per = SPG * 16;
            const int qblk = 15 - it / per, rem = it % per;
            const int type = rem & 1, h = (rem >> 1) & 7, lb = rem >> 4;
            const size_t r0 = (size_t)lb * 2048 + qblk * 128, k0 = (size_t)lb * 2048;
            const int ntl = 2 * qblk + 2, wl = wave < 2 ? ntl - 1 : ntl;
            if (type == 0)
              attn_item<0>(qb + r0 * 768 + h * 64, qb + r0 * 768 + 512 + h * 32, 768, knope + k0 * 512 + h * 64, krot + k0 * 32,
                           vtM + (size_t)(lb * 8 + h) * 64 * 2048, 2048, (dry ? dryb : qb) + r0 * 768 + h * 64, 768, 128, ntl, wl, 64, 0.f, 1.f, nullptr, lds);
            else
              attn_item<1>(dq + r0 * 512 + h * 64, nullptr, 512, dk + k0 * 512 + h * 64, nullptr,
                           dvT + (size_t)(lb * 8 + h) * 64 * 2048, 2048, (dry ? dryb : dq) + r0 * 512 + h * 64, 512, 128, ntl, wl, 64, lam, 1.f - lam_init, p.in[17] + l * 64, lds);
          }
        }
        }
      }
      xcd_barrier(xbar);

      if (PH & 32) {
        const int NU = (MTP >> 1) + (g == 0 ? 1 : 0);
        for (int it = 0; it < n_rounds(nblk, 8, NU); ++it) {
          LANEVARS
          int unit, nt; if (!map_tile(it, bid, nblk, 8, NU, unit, nt)) continue;
          const bool single = unit >= (MTP >> 1);
          const int mt0 = single ? MTP : 2 * unit;
          char* sbase = gst + (tid >> 2) * 2048 + (tid & 3) * 8;
          auto gate_epi = [&](const int s, const int mt, f32x4 (&acc)[4][4]) {
            const int xr = (mt >= MTP ? NPTOK : g * TG + mt * 128) + opq(wr * 64 + fr);
            char* sb = gst + opq((tid >> 2) * 2048 + (tid & 3) * 8);
#pragma unroll
            for (int mi = 0; mi < 4; ++mi) {
              const float rsv = rowscale16(ssq0, xr + mi * 16);
#pragma unroll
              for (int ni = 0; ni < 4; ++ni) {
                f32x4 v = acc[mi][ni] * rsv;
                v.x = sigm(v.x); v.y = sigm(v.y); v.z = sigm(v.z); v.w = sigm(v.w);
                *(u32x2*)(sb + s * 512 + (mi * 4 + ni) * 32) = pk4(v);
              }
            }
          };
          auto sum_epi = [&](const int s, const int mt, const int n, f32x4 (&acc)[4][4]) {
            const int rowq = opq(wr * 64 + fr);
            char* sb = gst + opq((tid >> 2) * 2048 + (tid & 3) * 8);
#pragma unroll
            for (int mi = 0; mi < 4; ++mi)
#pragma unroll
              for (int ni = 0; ni < 4; ++ni) {
                const u32x2 w = *(const u32x2*)(sb + s * 512 + (mi * 4 + ni) * 32);
                f32x4 gg; gg.x = __uint_as_float(w.x << 16); gg.y = __uint_as_float(w.x & 0xffff0000u); gg.z = __uint_as_float(w.y << 16); gg.w = __uint_as_float(w.y & 0xffff0000u);
                f32x4 t = gg * acc[mi][ni];
                char* ts = sb + 1024 + s * 512 + (mi * 4 + ni) * 32;
                if (n > 0) { const u32x2 pw = *(const u32x2*)ts; t.x += __uint_as_float(pw.x << 16); t.y += __uint_as_float(pw.x & 0xffff0000u); t.z += __uint_as_float(pw.y << 16); t.w += __uint_as_float(pw.y & 0xffff0000u); }
                if (n < 2) *(u32x2*)ts = pk4(t);
                else *(u32x2*)(mbuf + (size_t)(mt * 128 + rowq + mi * 16) * 1024 + nt * 128 + wc * 64 + ni * 16 + fq * 4) = pk4(t);
              }
          };
          const int xr0 = single ? NPTOK : g * TG + mt0 * 128;
#pragma unroll 1
          for (int n = 0; n < 3; ++n) {
            const bf16_t* Abr = n == 0 ? qb : (n == 1 ? hq : dq);
            const int ldbr = n == 0 ? 768 : 512;
            if (single) {
              f32x4 acc[4][4]; zero_acc(acc);
              gemm_tile<false>(xb + (size_t)xr0 * 1024, 1024, w_g + ((size_t)n * 1024 + nt * 128) * 1024, 1024, 1024, acc, lds);
              gate_epi(0, mt0, acc);
              zero_acc(acc);
              gemm_tile<false>(Abr + (size_t)mt0 * 128 * ldbr, ldbr, w_br + ((size_t)n * 1024 + nt * 128) * 512, 512, 512, acc, lds);
              sum_epi(0, mt0, n, acc);
            } else {
              f32x4 accA[4][4], accB[4][4]; zero_acc(accA); zero_acc(accB);
              gemm_pair<false>(xb + (size_t)xr0 * 1024, xb + (size_t)(single ? xr0 : xr0 + 128) * 1024, 1024, w_g + ((size_t)n * 1024 + nt * 128) * 1024, 1024, 1024, accA, accB, lds);
              gate_epi(0, mt0, accA);
              if (!single) gate_epi(1, mt0 + 1, accB);
              zero_acc(accA); zero_acc(accB);
              gemm_pair<false>(Abr + (size_t)mt0 * 128 * ldbr, Abr + (size_t)(single ? mt0 : mt0 + 1) * 128 * ldbr, ldbr, w_br + ((size_t)n * 1024 + nt * 128) * 512, 512, 512, accA, accB, lds);
              sum_epi(0, mt0, n, accA);
              if (!single) sum_epi(1, mt0 + 1, n, accB);
            }
          }
        }
      }
      xcd_barrier(xbar);

      if (PH & 64) {
        const int NU = (MTP >> 1) + (g == 0 ? 1 : 0);
        for (int it = 0; it < n_rounds(nblk, 8, NU); ++it) {
        LANEVARS
        int unit, nt; if (!map_tile(it, bid, nblk, 8, NU, unit, nt)) continue;
        auto epi = [&](const int mt, f32x4 (&acc)[4][4]) {
        const bool smp = mt >= MTP;
        const int xrow0 = smp ? NPTOK : g * TG + mt * 128;
#pragma unroll
        for (int mi = 0; mi < 4; ++mi) {
          const int rt = wr * 64 + mi * 16 + fr, xrow = xrow0 + rt, col = nt * 128 + wc * 64 + fq * 4;
          const float* rp = smp ? resS + (size_t)rt * 1024 + col : resP + (size_t)xrow * 1024 + col;
          float ss = 0.f;
#pragma unroll
          for (int ni = 0; ni < 4; ++ni) {
            const f32x4 x = *(const f32x4*)(rp + ni * 16) + acc[mi][ni];
            *(f32x4*)(out + (size_t)xrow * 1024 + col + ni * 16) = x;
            *(u32x2*)(xb + (size_t)xrow * 1024 + col + ni * 16) = pk4(x);
            ss += dot4(x);
          }
          ss = quadsum(ss);
          if (fq == 0) ssq1[(size_t)xrow * 16 + nt * 2 + wc] = ss;
        }
        };
        if (unit >= (MTP >> 1)) {
          const int mt = MTP;
          f32x4 acc[4][4]; zero_acc(acc);
          gemm_tile<false>(mbuf + (size_t)mt * 128 * 1024, 1024, w_out + (size_t)nt * 128 * 1024, 1024, 1024, acc, lds);
          epi(mt, acc);
        } else {
          const int mt = 2 * unit;
          f32x4 accA[4][4], accB[4][4]; zero_acc(accA); zero_acc(accB);
          gemm_pair<false>(mbuf + (size_t)mt * 128 * 1024, mbuf + (size_t)(mt + 1) * 128 * 1024, 1024, w_out + (size_t)nt * 128 * 1024, 1024, 1024, accA, accB, lds);
          epi(mt, accA);
          epi(mt + 1, accB);
        }
        }
      }
      xcd_barrier(xbar);

      if (PH & 128) {
        const int MT7 = SPG * 9 + (g == 0 ? 1 : 0);
        float* AL = (float*)lds;
        const float* cw = p.in[22] + (size_t)l * 3 * DFF;
        const float* cb = p.in[23] + (size_t)l * DFF;
        for (int it = 0; it < n_rounds(nblk, 44, MT7); ++it) {
          LANEVARS
          int unit, j; if (!map_tile(it, bid, nblk, 44, MT7, unit, j)) continue;
          const bool smp = unit >= SPG * 9;
          const int sq = smp ? 0 : unit / 9, uu = smp ? 0 : unit % 9;
          const int xbase = smp ? NPTOK : g * TG + sq * 2048;
          auto epi7 = [&](const int m, f32x4 (&acc)[4][4]) {
          const int t0 = smp ? 0 : 126 * m - 2;
          if (smp) {
#pragma unroll
            for (int i = 0; i < 4; ++i) { const int e = tid + i * 256, sb = e >> 7, rr = (e >> 6) & 1, f = e & 63; AL[(sb * 18 + rr) * 68 + f] = p.in[7][((size_t)(l * 8 + sb) * 2 + rr) * DFF + j * 64 + f]; }
          }
          float rs[4];
#pragma unroll
          for (int mi = 0; mi < 4; ++mi) {
            const int rt = wr * 64 + mi * 16 + fr;
            const int t = t0 + rt;
            const int tc = t < 0 ? 0 : (t > 2047 ? 2047 : t);
            rs[mi] = rowscale16(ssq1, smp ? xbase + rt : xbase + tc);
            const int lr = smp ? (rt >> 4) * 18 + 2 + (rt & 15) : rt;
#pragma unroll
            for (int np = 0; np < 2; ++np) {
              f32x4 a = acc[mi][2 * np] * rs[mi];
              if (!smp && t < 0) a = (f32x4){0.f, 0.f, 0.f, 0.f};
              const int fl = wc * 32 + np * 16 + fq * 4;
              *(f32x4*)(AL + lr * 68 + fl) = a;
              if (smp) { if ((rt & 15) >= 14) *(f32x4*)(out + O_SCONV + ((size_t)(l * 8 + (rt >> 4)) * 2 + ((rt & 15) - 14)) * DFF + j * 64 + fl) = a; }
              else if (m == 16 && (t == 2046 || t == 2047)) *(f32x4*)(out + O_PCONV + ((size_t)(l * 32 + g * SPG + sq) * 2 + (t - 2046)) * DFF + j * 64 + fl) = a;
            }
          }
          __syncthreads();
#pragma unroll
          for (int np = 0; np < 2; ++np) {
            const int fl = wc * 32 + np * 16 + fq * 4, f = j * 64 + fl;
            const f32x4 w0 = *(const f32x4*)(cw + f), w1 = *(const f32x4*)(cw + DFF + f), w2 = *(const f32x4*)(cw + 2 * DFF + f), b4 = *(const f32x4*)(cb + f);
#pragma unroll
            for (int mi = 0; mi < 4; ++mi) {
              const int rt = wr * 64 + mi * 16 + fr;
              const int t = t0 + rt;
              const bool valid = smp ? true : (rt >= 2 && t <= 2047);
              if (valid) {
                const int lr = smp ? (rt >> 4) * 18 + 2 + (rt & 15) : rt;
                const f32x4 a0 = *(const f32x4*)(AL + (lr - 2) * 68 + fl), a1 = *(const f32x4*)(AL + (lr - 1) * 68 + fl), a2 = *(const f32x4*)(AL + lr * 68 + fl);
                f32x4 c = b4 + w0 * a0 + w1 * a1 + w2 * a2;
                c.x = silu(c.x); c.y = silu(c.y); c.z = silu(c.z); c.w = silu(c.w);
                const f32x4 hv = c * (acc[mi][2 * np + 1] * rs[mi]);
                const size_t hrow = smp ? (size_t)TG + rt : (size_t)sq * 2048 + t;
                *(u32x2*)(hmid + hrow * DFF + f) = pk4(hv);
              }
            }
          }
          __syncthreads();
          };
          if (smp || uu == 8) {
            const int m = smp ? 0 : 16;
            f32x4 acc[4][4]; zero_acc(acc);
            gemm_tile<false, true>(xb + (size_t)xbase * 1024, 1024, w_up + (size_t)j * 128 * 1024, 1024, 1024, acc, lds, smp ? 0 : 126 * m - 2, 0, smp ? 127 : 2047);
            epi7(m, acc);
          } else {
            const int m0 = 2 * uu, m1 = 2 * uu + 1;
            f32x4 accA[4][4], accB[4][4]; zero_acc(accA); zero_acc(accB);
            gemm_pair<true>(xb + (size_t)xbase * 1024, xb + (size_t)xbase * 1024, 1024, w_up + (size_t)j * 128 * 1024, 1024, 1024, accA, accB, lds, 126 * m0 - 2, 126 * m1 - 2, 0, 2047);
            epi7(m0, accA);
            epi7(m1, accB);
          }
        }
      }
      xcd_barrier(xbar);

      if (PH & 256) {
        const int NU = (MTP >> 1) + (g == 0 ? 1 : 0);
        for (int it = 0; it < n_rounds(nblk, 8, NU); ++it) {
        LANEVARS
        int unit, nt; if (!map_tile(it, bid, nblk, 8, NU, unit, nt)) continue;
        auto epi = [&](const int mt, f32x4 (&acc)[4][4]) {
        const bool smp = mt >= MTP;
        const int xrow0 = smp ? NPTOK : g * TG + mt * 128;
#pragma unroll
        for (int mi = 0; mi < 4; ++mi) {
          const int rt = wr * 64 + mi * 16 + fr, xrow = xrow0 + rt, col = nt * 128 + wc * 64 + fq * 4;
          float* rp = out + (size_t)xrow * 1024 + col;
          float ss = 0.f;
#pragma unroll
          for (int ni = 0; ni < 4; ++ni) {
            const f32x4 x = *(const f32x4*)(rp + ni * 16) + acc[mi][ni];
            *(f32x4*)(rp + ni * 16) = x;
            *(u32x2*)(xb + (size_t)xrow * 1024 + col + ni * 16) = pk4(x);
            ss += dot4(x);
          }
          ss = quadsum(ss);
          if (fq == 0) ssq0[(size_t)xrow * 16 + nt * 2 + wc] = ss;
        }
        };
        if (unit >= (MTP >> 1)) {
          const int mt = MTP;
          f32x4 acc[4][4]; zero_acc(acc);
          gemm_tile<false>(hmid + (size_t)mt * 128 * DFF, DFF, w_down + (size_t)nt * 128 * DFF, DFF, DFF, acc, lds);
          epi(mt, acc);
        } else {
          const int mt = 2 * unit;
          f32x4 accA[4][4], accB[4][4]; zero_acc(accA); zero_acc(accB);
          gemm_pair<false>(hmid + (size_t)mt * 128 * DFF, hmid + (size_t)(mt + 1) * 128 * DFF, DFF, w_down + (size_t)nt * 128 * DFF, DFF, DFF, accA, accB, lds);
          epi(mt, accA);
          epi(mt + 1, accB);
        }
        }
      }
      xcd_barrier(xbar);
    }
  }
  {
    const int tid = opq((int)threadIdx.x);
    const f32x4 g4 = *(const f32x4*)(p.in[25] + tid * 4);
    for (int row0 = bid * 4; row0 < NPTOK + NSTOK; row0 += nblk * 4) {
      f32x4 v[4]; float r[4];
#pragma unroll
      for (int k = 0; k < 4; ++k) { v[k] = *(const f32x4*)(out + (size_t)(row0 + k) * 1024 + tid * 4); r[k] = rowscale16(ssq0, row0 + k); }
#pragma unroll
      for (int k = 0; k < 4; ++k) *(f32x4*)(out + (size_t)(row0 + k) * 1024 + tid * 4) = v[k] * r[k] * g4;
    }
  }
}

extern "C" void kernel_launch(void* const* d_in, const int* in_sizes, int n_in, void* d_out, int out_size, void* d_ws, size_t ws_size, hipStream_t stream) {
  static int grid_blocks = 0;
  if (!grid_blocks) {
    int dev = 0, cus = 0, per = 0;
    (void)hipGetDevice(&dev);
    (void)hipDeviceGetAttribute(&cus, hipDeviceAttributeMultiprocessorCount, dev);
    (void)hipOccupancyMaxActiveBlocksPerMultiprocessor(&per, fwd_megakernel, 256, 0);
    grid_blocks = cus * per;
    if (grid_blocks > MAXGRID) grid_blocks = MAXGRID;
    if (grid_blocks < 1) grid_blocks = 1;
  }
  Params p{};
  for (int i = 0; i < 26; ++i) p.in[i] = (const float*)d_in[i];
  p.out = (float*)d_out;
  p.ws = (char*)d_ws;
  int ng = 1;
  for (; ng < 8; ng *= 2) { Layout L; make_layout(ng, L); if (L.total + (DRY4 ? (size_t)70000 * 1536 : 0) <= ws_size) break; }
  p.ng = ng;
  p.pad = 0;
  { Layout L; make_layout(ng, L); (void)hipMemsetAsync((char*)d_ws + L.bar, 0, XCD_BAR_WORDS * 4, stream); }
  void* args[] = {&p};
  hipError_t e = hipLaunchCooperativeKernel((void*)fwd_megakernel, dim3(grid_blocks), dim3(256), args, 0, stream);
  if (e != hipSuccess) fprintf(stderr, "cooperative launch failed: %s (grid %d)\n", hipGetErrorString(e), grid_blocks);
}
```

```cpp
#include <hip/hip_runtime.h>
#include <hip/hip_cooperative_groups.h>
#include <cstdio>
#include <cstdint>
namespace cg = cooperative_groups;

typedef unsigned short bf16_t;
typedef short bf16x8 __attribute__((ext_vector_type(8)));
typedef float f32x4 __attribute__((ext_vector_type(4)));
typedef float f32x2 __attribute__((ext_vector_type(2)));
typedef unsigned u32x4 __attribute__((ext_vector_type(4)));
typedef unsigned u32x2 __attribute__((ext_vector_type(2)));
#define DI __device__ __forceinline__
#define LANEVARS const int tid = opq((int)threadIdx.x), lane = tid & 63, wave = tid >> 6, wr = wave >> 1, wc = wave & 1, fr = lane & 15, fq = lane >> 4; (void)lane; (void)wave; (void)wr; (void)wc; (void)fr; (void)fq;
#define MFMA16(a, b, c) __builtin_amdgcn_mfma_f32_16x16x32_bf16((a), (b), (c), 0, 0, 0)

constexpr int NPTOK = 65536, NSTOK = 128;
constexpr int KS_LD = 2112;
constexpr float EPS = 1e-6f;
constexpr float LOG2E = 1.4426950408889634f;
constexpr float QS_MLA = 0.10206207261596577f * LOG2E;
constexpr float QS_DF = 0.17677669529663687f * LOG2E;
constexpr int DFF = 2816;
constexpr int LDS_BYTES = 73728;
constexpr int MAXGRID = 512;
#ifndef DRY4
#define DRY4 0
#endif
#ifndef REP2
#define REP2 1
#endif
#ifndef REP7
#define REP7 1
#endif
#ifndef PH
#define PH 0x1ff
#endif

constexpr size_t O_YP = 0;
constexpr size_t O_YS = O_YP + (size_t)NPTOK * 1024;
constexpr size_t O_PCKV = O_YS + (size_t)NSTOK * 1024;
constexpr size_t O_PKR = O_PCKV + (size_t)2 * NPTOK * 256;
constexpr size_t O_PDK = O_PKR + (size_t)2 * NPTOK * 32;
constexpr size_t O_PDV = O_PDK + (size_t)2 * NPTOK * 512;
constexpr size_t O_PHG = O_PDV + (size_t)2 * NPTOK * 512;
constexpr size_t O_PCONV = O_PHG + (size_t)2 * 32 * 8 * 64 * 64;
constexpr size_t O_SCKV = O_PCONV + (size_t)2 * 32 * 2 * DFF;
constexpr size_t O_SKR = O_SCKV + (size_t)2 * NSTOK * 256;
constexpr size_t O_SDK = O_SKR + (size_t)2 * NSTOK * 32;
constexpr size_t O_SDV = O_SDK + (size_t)2 * NSTOK * 512;
constexpr size_t O_SHG = O_SDV + (size_t)2 * NSTOK * 512;
constexpr size_t O_SCONV = O_SHG + (size_t)2 * 8 * 8 * 64 * 64;

struct Params {
  const float* in[26];
  float* out;
  char* ws;
  int ng;
  int pad;
};

struct Layout {
  size_t w_in, w_g, w_uq, w_ukvG, w_ukvP, w_br, w_out, w_up, w_down, rope, ctr, bar, xb, ssq0, ssq1, ssqq, ssqkv, qlat, q, kvlat, krot, kv,
      hq, hf, hi, hg, dq, dk, dvT, ckvS, knopeS, vtMS, krotS, dKS, dVtS, gst, total;
};
__host__ __device__ __forceinline__ size_t al256(size_t b) { return (b + 255) & ~(size_t)255; }
__host__ __device__ __forceinline__ void make_layout(int ng, Layout& L) {
  size_t o = 0;
  const size_t TG = (size_t)(32 / ng) * 2048, R = TG + 128;
#define TAKE(field, bytes) L.field = o; o += al256((size_t)(bytes));
  TAKE(w_in, 4352 * 1024 * 2) TAKE(w_g, 3072 * 1024 * 2) TAKE(w_uq, 768 * 384 * 2) TAKE(w_ukvG, 1024 * 256 * 2) TAKE(w_ukvP, 1024 * 256 * 2)
  TAKE(w_br, 3 * 1024 * 512 * 2) TAKE(w_out, 1024 * 1024 * 2) TAKE(w_up, 5632 * 1024 * 2) TAKE(w_down, 1024 * 2816 * 2)
  TAKE(rope, 2064 * 16 * 8) TAKE(ctr, 256) TAKE(bar, 16384)
  TAKE(xb, (size_t)(NPTOK + NSTOK) * 1024 * 2) TAKE(ssq0, (size_t)(NPTOK + NSTOK) * 16 * 4) TAKE(ssq1, (size_t)(NPTOK + NSTOK) * 16 * 4)
  TAKE(ssqq, R * 8 * 4) TAKE(ssqkv, R * 4 * 4)
  TAKE(qlat, R * 384 * 2) TAKE(kvlat, R * 256 * 2) TAKE(q, R * 768 * 2) TAKE(krot, R * 32 * 2)
  TAKE(kv, R * 2048)
  TAKE(hq, R * 1024) TAKE(hf, R * 1024) TAKE(hi, R * 1024) TAKE(hg, R * 1024) TAKE(dq, R * 1024) TAKE(dk, R * 1024) TAKE(dvT, R * 1024)
  TAKE(ckvS, 16384 * 256 * 2) TAKE(knopeS, 8 * KS_LD * 512 * 2) TAKE(vtMS, 8 * 512 * KS_LD * 2) TAKE(krotS, 8 * KS_LD * 32 * 2)
  TAKE(dKS, 8 * KS_LD * 512 * 2) TAKE(dVtS, 8 * 512 * KS_LD * 2)
  if (ng == 1) { L.gst = L.qlat; } else { TAKE(gst, (size_t)MAXGRID * 131072) }
#undef TAKE
  L.total = o;
}

DI int opq(int x) { asm volatile("" : "+v"(x)); return x; }
DI unsigned pk2(float lo, float hi) { unsigned r; asm("v_cvt_pk_bf16_f32 %0, %1, %2" : "=v"(r) : "v"(lo), "v"(hi)); return r; }
DI u32x2 pk4(f32x4 v) { u32x2 r; r.x = pk2(v.x, v.y); r.y = pk2(v.z, v.w); return r; }
DI float sigm(float x) { return 1.f / (1.f + __expf(-x)); }
DI float silu(float x) { return x * sigm(x); }
DI float ex2(float x) { return __builtin_amdgcn_exp2f(x); }
DI float dot4(f32x4 v) { return (v.x * v.x + v.y * v.y) + (v.z * v.z + v.w * v.w); }
DI float quadsum(float s) { s += __shfl_xor(s, 16); s += __shfl_xor(s, 32); return s; }
DI float quadmax(float s) { s = fmaxf(s, __shfl_xor(s, 16)); s = fmaxf(s, __shfl_xor(s, 32)); return s; }
DI float rowscale16(const float* ssq, int xrow) {
  const f32x4* p = (const f32x4*)(ssq + (size_t)xrow * 16);
  f32x4 a = p[0], b = p[1], c = p[2], d = p[3];
  float s = (((a.x + a.y) + (a.z + a.w)) + ((b.x + b.y) + (b.z + b.w))) + (((c.x + c.y) + (c.z + c.w)) + ((d.x + d.y) + (d.z + d.w)));
  return rsqrtf(s * (1.f / 1024.f) + EPS);
}
DI float rowscale_kv(const float* ssqkv, int rl) {
  f32x4 a = *(const f32x4*)(ssqkv + (size_t)rl * 4);
  return rsqrtf(((a.x + a.y) + (a.z + a.w)) * (1.f / 256.f) + EPS);
}

constexpr int LDT_B = 144;
constexpr int TILE_B = 128 * LDT_B;
template <bool MODEN, bool CLAMP = false>
DI void gemm_tile(const bf16_t* __restrict__ A, int lda, const bf16_t* __restrict__ B, int ldb, int K, f32x4 (&acc)[4][4], char* lds, int aro = 0, int arlo = 0, int arhi = 1 << 30) {
  const int tid = opq((int)threadIdx.x), lane = tid & 63, wave = tid >> 6, wr = wave >> 1, wc = wave & 1, fr = lane & 15, fq = lane >> 4;
  const int lrow = tid >> 3, lkc = tid & 7;
  const bf16_t* ap[4];
#pragma unroll
  for (int i = 0; i < 4; ++i) {
    if (CLAMP) { int Ra = lrow + 32 * i + aro; Ra = Ra < arlo ? arlo : (Ra > arhi ? arhi : Ra); ap[i] = A + (ptrdiff_t)Ra * lda + lkc * 8; }
    else ap[i] = A + (size_t)lrow * lda + lkc * 8 + (size_t)(32 * i) * lda;
  }
  const bf16_t* bp = B + (size_t)lrow * ldb + lkc * 8;
  const int st_off = lrow * LDT_B + lkc * 16;
  const int a_off = (wr * 64 + fr) * LDT_B + fq * 16;
  const int b_off = TILE_B + (wc * 64 + fr) * LDT_B + fq * 16;
  u32x4 ra0[4], rb0[4], ra1[4], rb1[4];
#define G_LOAD(RA, RB, ko) _Pragma("unroll") for (int i = 0; i < 4; ++i) { RA[i] = *(const u32x4*)(ap[i] + (ko)); RB[i] = *(const u32x4*)(bp + (size_t)(32 * i) * ldb + (ko)); }
#define G_STORE(RA, RB, base) _Pragma("unroll") for (int i = 0; i < 4; ++i) { *(u32x4*)(lds + (base) + st_off + i * 32 * LDT_B) = RA[i]; *(u32x4*)(lds + (base) + TILE_B + st_off + i * 32 * LDT_B) = RB[i]; }
#define G_COMPUTE(base) _Pragma("unroll") for (int ks = 0; ks < 2; ++ks) { \
      bf16x8 af[4], bfr[4]; \
      _Pragma("unroll") for (int i = 0; i < 4; ++i) { af[i] = *(const bf16x8*)(lds + (base) + a_off + i * 16 * LDT_B + ks * 64); bfr[i] = *(const bf16x8*)(lds + (base) + b_off + i * 16 * LDT_B + ks * 64); } \
      _Pragma("unroll") for (int mi = 0; mi < 4; ++mi) _Pragma("unroll") for (int ni = 0; ni < 4; ++ni) acc[mi][ni] = MODEN ? MFMA16(af[mi], bfr[ni], acc[mi][ni]) : MFMA16(bfr[ni], af[mi], acc[mi][ni]); }
  G_LOAD(ra0, rb0, 0)
  G_LOAD(ra1, rb1, 64)
  G_STORE(ra0, rb0, 0)
  __syncthreads();
  const int nk = K >> 6;
  for (int kt = 0; kt < nk; kt += 2) {
    if (kt + 2 < nk) { G_LOAD(ra0, rb0, (kt + 2) * 64) }
    G_COMPUTE(0)
    G_STORE(ra1, rb1, 2 * TILE_B)
    __syncthreads();
    if (kt + 3 < nk) { G_LOAD(ra1, rb1, (kt + 3) * 64) }
    G_COMPUTE(2 * TILE_B)
    if (kt + 2 < nk) { G_STORE(ra0, rb0, 0) }
    __syncthreads();
  }
#undef G_LOAD
#undef G_STORE
#undef G_COMPUTE
}
constexpr int OPT_B = 8192, SLOT3_B = 24576;
DI int lds_byte32(int r, int c) { const int ob = (r & 15) * 64 + c * 2; return (r >> 4) * 1024 + (ob ^ (((ob >> 9) & 1) << 5)); }
DI void stage_rc32(int b, int& R, int& C) { const int sb = b & 1023, swz = sb ^ (((sb >> 9) & 1) << 5); R = (b >> 10) * 16 + (swz >> 6); C = (swz & 63) >> 1; }
template <bool CLAMP = false>
DI void gemm_pair(const bf16_t* __restrict__ A0, const bf16_t* __restrict__ A1, int lda, const bf16_t* __restrict__ B, int ldb, int K,
                  f32x4 (&acc0)[4][4], f32x4 (&acc1)[4][4], char* lds, int aro0 = 0, int aro1 = 0, int arlo = 0, int arhi = 1 << 30) {
  const int tid = opq((int)threadIdx.x), lane = tid & 63, wave = tid >> 6, wr = wave >> 1, wc = wave & 1, fr = lane & 15, fq = lane >> 4;
  const bf16_t* g0[2]; const bf16_t* g1[2]; const bf16_t* gb[2];
#pragma unroll
  for (int i = 0; i < 2; ++i) {
    int R, C; stage_rc32(tid * 16 + i * 4096, R, C);
    int R0 = R, R1 = R;
    if (CLAMP) { R0 = R + aro0; R0 = R0 < arlo ? arlo : (R0 > arhi ? arhi : R0); R1 = R + aro1; R1 = R1 < arlo ? arlo : (R1 > arhi ? arhi : R1); }
    g0[i] = A0 + (size_t)R0 * lda + C; g1[i] = A1 + (size_t)R1 * lda + C; gb[i] = B + (size_t)R * ldb + C;
  }
  const int fo = lds_byte32(fr, fq * 8);
  const int a_base = wr * 4096 + fo, b_base = 2 * OPT_B + wc * 4096 + fo;
#define P_STAGE(sb, ko) _Pragma("unroll") for (int i = 0; i < 2; ++i) { \
    __builtin_amdgcn_global_load_lds((const unsigned*)(g0[i] + (ko)), (__attribute__((address_space(3))) unsigned*)(lds + (sb) + tid * 16 + i * 4096), 16, 0, 0); \
    __builtin_amdgcn_global_load_lds((const unsigned*)(g1[i] + (ko)), (__attribute__((address_space(3))) unsigned*)(lds + (sb) + OPT_B + tid * 16 + i * 4096), 16, 0, 0); \
    __builtin_amdgcn_global_load_lds((const unsigned*)(gb[i] + (ko)), (__attribute__((address_space(3))) unsigned*)(lds + (sb) + 2 * OPT_B + tid * 16 + i * 4096), 16, 0, 0); }
  const int nk = K >> 5;
  P_STAGE(0, 0)
  P_STAGE(SLOT3_B, 32)
  int cur = 0, nxt2 = 2 * SLOT3_B;
  for (int kt = 0; kt < nk; ++kt) {
    if (kt + 1 < nk) asm volatile("s_waitcnt vmcnt(6) lgkmcnt(0)" ::: "memory"); else asm volatile("s_waitcnt vmcnt(0) lgkmcnt(0)" ::: "memory");
    __builtin_amdgcn_s_barrier();
    if (kt + 2 < nk) { P_STAGE(nxt2, (kt + 2) * 32) }
    bf16x8 a0f[4], a1f[4], bfr[4];
#pragma unroll
    for (int i = 0; i < 4; ++i) { a0f[i] = *(const bf16x8*)(lds + cur + a_base + i * 1024); a1f[i] = *(const bf16x8*)(lds + cur + OPT_B + a_base + i * 1024); bfr[i] = *(const bf16x8*)(lds + cur + b_base + i * 1024); }
#pragma unroll
    for (int mi = 0; mi < 4; ++mi)
#pragma unroll
      for (int ni = 0; ni < 4; ++ni) { acc0[mi][ni] = MFMA16(bfr[ni], a0f[mi], acc0[mi][ni]); acc1[mi][ni] = MFMA16(bfr[ni], a1f[mi], acc1[mi][ni]); }
    const int t = cur; cur = (cur == 2 * SLOT3_B) ? 0 : cur + SLOT3_B; nxt2 = t;
  }
  __syncthreads();
#undef P_STAGE
}
DI bool map_tile(int it, int bid, int nblk, int NT, int MT, int& mt, int& nt) {
  const int tp = (it * 8 + (bid & 7)) * (nblk >> 3) + (bid >> 3);
  const int per = NT * 8;
  const int mg = tp / per, r = tp - mg * per;
  nt = r >> 3; mt = mg * 8 + (r & 7);
  return mt < MT;
}
DI int n_rounds(int nblk, int NT, int MT) { return (((MT + 7) >> 3) * 8 * NT + nblk - 1) / nblk; }
DI void zero_acc(f32x4 (&acc)[4][4]) {
#pragma unroll
  for (int i = 0; i < 4; ++i)
#pragma unroll
    for (int j = 0; j < 4; ++j) acc[i][j] = (f32x4){0.f, 0.f, 0.f, 0.f};
}

DI int mapcol(int kind, int n) {
  switch (kind) {
    case 1: return n < 640 ? n : (n < 4224 ? n + 32 : (n < 4256 ? n - 4224 + 640 : -1));
    case 2: return n + 4256;
    case 3: return n < 512 ? (n >> 6) * 96 + (n & 63) : ((n - 512) >> 5) * 96 + 64 + ((n - 512) & 31);
    case 4: return n < 512 ? (n >> 6) * 128 + (n & 63) : ((n - 512) >> 6) * 128 + 64 + (n & 63);
    case 5: { const int j = n >> 7, c = n & 127, wc = c >> 6, ni = (c >> 4) & 3, x = c & 15; const int f = j * 64 + wc * 32 + (ni >> 1) * 16 + x; return (ni & 1) ? DFF + f : f; }
    default: return n;
  }
}
DI void conv_tile(const float* __restrict__ W, int ldw, const float* __restrict__ ksc, int kind, bf16_t* __restrict__ out, int ldo, int tn, int tk, char* lds) {
  float* T = (float*)lds;
  const int tid = opq((int)threadIdx.x), nn = tid & 63, kk0 = tid >> 6;
  const int src = mapcol(kind, tn * 64 + nn);
  float wv[16];
#pragma unroll
  for (int i = 0; i < 16; ++i) wv[i] = src >= 0 ? W[(size_t)(tk * 64 + kk0 + 4 * i) * ldw + src] : 0.f;
#pragma unroll
  for (int i = 0; i < 16; ++i) {
    const int k = kk0 + 4 * i;
    T[k * 65 + nn] = ksc ? wv[i] * ksc[tk * 64 + k] : wv[i];
  }
  __syncthreads();
  const int n = tid >> 2, kq = tid & 3;
  u32x4 o0, o1;
  o0.x = pk2(T[(kq * 16 + 0) * 65 + n], T[(kq * 16 + 1) * 65 + n]); o0.y = pk2(T[(kq * 16 + 2) * 65 + n], T[(kq * 16 + 3) * 65 + n]);
  o0.z = pk2(T[(kq * 16 + 4) * 65 + n], T[(kq * 16 + 5) * 65 + n]); o0.w = pk2(T[(kq * 16 + 6) * 65 + n], T[(kq * 16 + 7) * 65 + n]);
  o1.x = pk2(T[(kq * 16 + 8) * 65 + n], T[(kq * 16 + 9) * 65 + n]); o1.y = pk2(T[(kq * 16 + 10) * 65 + n], T[(kq * 16 + 11) * 65 + n]);
  o1.z = pk2(T[(kq * 16 + 12) * 65 + n], T[(kq * 16 + 13) * 65 + n]); o1.w = pk2(T[(kq * 16 + 14) * 65 + n], T[(kq * 16 + 15) * 65 + n]);
  bf16_t* op = out + (size_t)(tn * 64 + n) * ldo + tk * 64 + kq * 16;
  *(u32x4*)op = o0; *(u32x4*)(op + 8) = o1;
  __syncthreads();
}

template <int TYPE>
DI void attn_item(const bf16_t* __restrict__ Q, const bf16_t* __restrict__ Q2, int ldq, const bf16_t* __restrict__ K1, const bf16_t* __restrict__ K2,
                  const bf16_t* __restrict__ Vt, int ldv, bf16_t* __restrict__ O, int ldo, int nq, int ntiles, int wlimit, int nlast,
                  float lam, float oscale, const float* __restrict__ gn, char* lds) {
  constexpr int DK = TYPE == 0 ? 96 : 64;
  constexpr int KLD = (DK + 8) * 2;
  constexpr int KT_B = 64 * KLD;
  constexpr int VLD = 144;
  constexpr int VT_B = 64 * VLD;
  constexpr int ST_B = KT_B + VT_B;
  constexpr int NKCH = DK / 8;
  constexpr int NKL = 64 * NKCH / 256;
  constexpr int NMAP = TYPE == 0 ? 1 : 2;
  constexpr int NKS = TYPE == 0 ? 3 : 1;
  const int tid = opq((int)threadIdx.x), lane = tid & 63, wave = tid >> 6, fr = lane & 15, fq = lane >> 4;

  bf16x8 qf[NMAP][2][NKS];
#pragma unroll
  for (int qg = 0; qg < 2; ++qg) {
    int row = wave * 32 + qg * 16 + fr; row = row < nq ? row : nq - 1;
    if (TYPE == 0) {
      qf[0][qg][0] = *(const bf16x8*)(Q + (size_t)row * ldq + fq * 8);
      qf[0][qg][NKS > 1 ? 1 : 0] = *(const bf16x8*)(Q + (size_t)row * ldq + 32 + fq * 8);
      qf[0][qg][NKS - 1] = *(const bf16x8*)(Q2 + (size_t)row * ldq + fq * 8);
    } else {
      qf[0][qg][0] = *(const bf16x8*)(Q + (size_t)row * ldq + fq * 8);
      qf[NMAP - 1][qg][0] = *(const bf16x8*)(Q + (size_t)row * ldq + 32 + fq * 8);
    }
  }
  f32x4 o[NMAP][2][4];
  float mrun[NMAP][2], lrun[NMAP][2];
#pragma unroll
  for (int j = 0; j < NMAP; ++j)
#pragma unroll
    for (int qg = 0; qg < 2; ++qg) {
      mrun[j][qg] = -1e30f; lrun[j][qg] = 0.f;
#pragma unroll
      for (int dt = 0; dt < 4; ++dt) o[j][qg][dt] = (f32x4){0.f, 0.f, 0.f, 0.f};
    }

  u32x4 kr[NKL], vr[2];
#pragma unroll
  for (int i = 0; i < NKL; ++i) {
    const int c = tid + i * 256, key = c / NKCH, part = c % NKCH;
    const bf16_t* src = (TYPE == 0 && part >= 8) ? K2 + (size_t)key * 32 + (part - 8) * 8 : K1 + (size_t)key * 512 + part * 8;
    kr[i] = *(const u32x4*)src;
  }
#pragma unroll
  for (int i = 0; i < 2; ++i) { const int c = tid + i * 256, d = c >> 3, part = c & 7; vr[i] = *(const u32x4*)(Vt + (size_t)d * ldv + part * 8); }
#pragma unroll
  for (int i = 0; i < NKL; ++i) { const int c = tid + i * 256, key = c / NKCH, part = c % NKCH; *(u32x4*)(lds + key * KLD + part * 16) = kr[i]; }
#pragma unroll
  for (int i = 0; i < 2; ++i) { const int c = tid + i * 256, d = c >> 3, part = c & 7; *(u32x4*)(lds + KT_B + d * VLD + part * 16) = vr[i]; }
  __syncthreads();

  for (int kt = 0; kt < ntiles; ++kt) {
    const int cur = (kt & 1) * ST_B;
    const bool more = kt + 1 < ntiles;
    if (more) {
      const size_t k0 = (size_t)(kt + 1) * 64;
#pragma unroll
      for (int i = 0; i < NKL; ++i) {
        const int c = tid + i * 256, key = c / NKCH, part = c % NKCH;
        const bf16_t* src = (TYPE == 0 && part >= 8) ? K2 + (k0 + key) * 32 + (part - 8) * 8 : K1 + (k0 + key) * 512 + part * 8;
        kr[i] = *(const u32x4*)src;
      }
#pragma unroll
      for (int i = 0; i < 2; ++i) { const int c = tid + i * 256, d = c >> 3, part = c & 7; vr[i] = *(const u32x4*)(Vt + (size_t)d * ldv + k0 + part * 8); }
    }
    if (kt < wlimit) {
      bf16x8 pf[NMAP][2][2];
#pragma unroll
      for (int j = 0; j < NMAP; ++j) {
        f32x4 s[2][4];
#pragma unroll
        for (int qg = 0; qg < 2; ++qg)
#pragma unroll
          for (int kk = 0; kk < 4; ++kk) s[qg][kk] = (f32x4){0.f, 0.f, 0.f, 0.f};
        __builtin_amdgcn_s_setprio(1);
#pragma unroll
        for (int kk = 0; kk < 4; ++kk) {
#pragma unroll
          for (int ks = 0; ks < NKS; ++ks) {
            const bf16x8 kf = *(const bf16x8*)(lds + cur + (kk * 16 + fr) * KLD + (j * 32 + ks * 32 + fq * 8) * 2);
#pragma unroll
            for (int qg = 0; qg < 2; ++qg) s[qg][kk] = MFMA16(kf, qf[j][qg][ks], s[qg][kk]);
          }
        }
        __builtin_amdgcn_s_setprio(0);
        if (kt == ntiles - 1 && nlast < 64) {
#pragma unroll
          for (int qg = 0; qg < 2; ++qg)
#pragma unroll
            for (int kk = 0; kk < 4; ++kk) {
              const int key = kk * 16 + fq * 4;
              if (key + 0 >= nlast) s[qg][kk].x = -1e30f;
              if (key + 1 >= nlast) s[qg][kk].y = -1e30f;
              if (key + 2 >= nlast) s[qg][kk].z = -1e30f;
              if (key + 3 >= nlast) s[qg][kk].w = -1e30f;
            }
        }
#pragma unroll
        for (int qg = 0; qg < 2; ++qg) {
          float mx = -1e30f;
#pragma unroll
          for (int kk = 0; kk < 4; ++kk) mx = fmaxf(mx, fmaxf(fmaxf(s[qg][kk].x, s[qg][kk].y), fmaxf(s[qg][kk].z, s[qg][kk].w)));
          mx = quadmax(mx);
          if (!__all(mx - mrun[j][qg] <= 8.0f)) {
            const float mnew = fmaxf(mrun[j][qg], mx);
            const float al = ex2(mrun[j][qg] - mnew);
            mrun[j][qg] = mnew;
            lrun[j][qg] *= al;
#pragma unroll
            for (int dt = 0; dt < 4; ++dt) o[j][qg][dt] *= al;
          }
          const float mn = mrun[j][qg];
          float ps = 0.f;
#pragma unroll
          for (int kk = 0; kk < 4; ++kk) {
            f32x4 pp;
            pp.x = ex2(s[qg][kk].x - mn); pp.y = ex2(s[qg][kk].y - mn); pp.z = ex2(s[qg][kk].z - mn); pp.w = ex2(s[qg][kk].w - mn);
            ps += (pp.x + pp.y) + (pp.z + pp.w);
            s[qg][kk] = pp;
          }
          lrun[j][qg] += ps;
#pragma unroll
          for (int s2 = 0; s2 < 2; ++s2) {
            u32x4 w;
            w.x = pk2(s[qg][2 * s2].x, s[qg][2 * s2].y); w.y = pk2(s[qg][2 * s2].z, s[qg][2 * s2].w);
            w.z = pk2(s[qg][2 * s2 + 1].x, s[qg][2 * s2 + 1].y); w.w = pk2(s[qg][2 * s2 + 1].z, s[qg][2 * s2 + 1].w);
            pf[j][qg][s2] = __builtin_bit_cast(bf16x8, w);
          }
        }
      }
      __builtin_amdgcn_s_setprio(1);
#pragma unroll
      for (int dt = 0; dt < 4; ++dt)
#pragma unroll
        for (int s2 = 0; s2 < 2; ++s2) {
          const char* vb = lds + cur + KT_B + (dt * 16 + fr) * VLD + (32 * s2 + fq * 4) * 2;
          const u32x2 lo = *(const u32x2*)vb, hi = *(const u32x2*)(vb + 32);
          u32x4 w; w.x = lo.x; w.y = lo.y; w.z = hi.x; w.w = hi.y;
          const bf16x8 vf = __builtin_bit_cast(bf16x8, w);
#pragma unroll
          for (int j = 0; j < NMAP; ++j)
#pragma unroll
            for (int qg = 0; qg < 2; ++qg) o[j][qg][dt] = MFMA16(vf, pf[j][qg][s2], o[j][qg][dt]);
        }
      __builtin_amdgcn_s_setprio(0);
    }
    if (more) {
      const int nxt = ST_B - cur;
#pragma unroll
      for (int i = 0; i < NKL; ++i) { const int c = tid + i * 256, key = c / NKCH, part = c % NKCH; *(u32x4*)(lds + nxt + key * KLD + part * 16) = kr[i]; }
#pragma unroll
      for (int i = 0; i < 2; ++i) { const int c = tid + i * 256, d = c >> 3, part = c & 7; *(u32x4*)(lds + nxt + KT_B + d * VLD + part * 16) = vr[i]; }
    }
    __syncthreads();
  }
#pragma unroll
  for (int qg = 0; qg < 2; ++qg) {
    const int row = wave * 32 + qg * 16 + fr;
    if (TYPE == 0) {
      const float inv = 1.f / quadsum(lrun[0][qg]);
      if (row < nq) {
#pragma unroll
        for (int dt = 0; dt < 4; ++dt) *(u32x2*)(O + (size_t)row * ldo + dt * 16 + fq * 4) = pk4(o[0][qg][dt] * inv);
      }
    } else {
      const float inv0 = 1.f / quadsum(lrun[0][qg]);
      const float inv1 = lam / quadsum(lrun[NMAP - 1][qg]);
      f32x4 v[4];
      float ss = 0.f;
#pragma unroll
      for (int dt = 0; dt < 4; ++dt) { v[dt] = o[0][qg][dt] * inv0 - o[NMAP - 1][qg][dt] * inv1; ss += dot4(v[dt]); }
      ss = quadsum(ss);
      const float r = rsqrtf(ss * (1.f / 64.f) + EPS) * oscale;
      if (row < nq) {
#pragma unroll
        for (int dt = 0; dt < 4; ++dt) { const f32x4 g4 = *(const f32x4*)(gn + dt * 16 + fq * 4); *(u32x2*)(O + (size_t)row * ldo + dt * 16 + fq * 4) = pk4(v[dt] * r * g4); }
      }
    }
  }
}

DI void hgrn_unit(const bf16_t* hq, bf16_t* ob, const bf16_t* __restrict__ hf, const bf16_t* __restrict__ hi, const bf16_t* __restrict__ hg, int h, int T,
                  const float* __restrict__ S0, float* __restrict__ Sout, const float* __restrict__ lbl, int layer, const float* __restrict__ gn, char* lds) {
  constexpr int CH = 32;
  float* qL = (float*)lds;
  float* kL = qL + CH * 64;
  float* vL = kL + CH * 64;
  float* oP = vL + CH * 64;
  const int tid = opq((int)threadIdx.x), vv = tid & 63, kq = tid >> 6;
  const int lt = tid >> 3, part = tid & 7;
  f32x2 S[8];
#pragma unroll
  for (int i = 0; i < 8; ++i) { S[i].x = S0 ? S0[(size_t)(kq * 16 + 2 * i) * 64 + vv] : 0.f; S[i].y = S0 ? S0[(size_t)(kq * 16 + 2 * i + 1) * 64 + vv] : 0.f; }
  float omlb[8];
#pragma unroll
  for (int i = 0; i < 8; ++i) {
    const int kc = h * 64 + part * 8 + i;
    omlb[i] = layer == 0 ? 1.f : sigm(lbl[kc] - lbl[512 + kc]);
  }
  const f32x4 gv0 = *(const f32x4*)(gn + part * 8), gv1 = *(const f32x4*)(gn + part * 8 + 4);
  const int nch = (T + CH - 1) / CH;
  u32x4 rq, rk, rv;
  {
    const int t = lt < T ? lt : T - 1;
    const size_t off = (size_t)t * 512 + h * 64 + part * 8;
    rq = *(const u32x4*)(hq + off); rk = *(const u32x4*)(hf + off); rv = *(const u32x4*)(hi + off);
  }
  for (int c = 0; c < nch; ++c) {
    {
      const int e = lt * 64 + part * 8;
      qL[e + 0] = __uint_as_float(rq.x << 16); qL[e + 1] = __uint_as_float(rq.x & 0xffff0000u);
      qL[e + 2] = __uint_as_float(rq.y << 16); qL[e + 3] = __uint_as_float(rq.y & 0xffff0000u);
      qL[e + 4] = __uint_as_float(rq.z << 16); qL[e + 5] = __uint_as_float(rq.z & 0xffff0000u);
      qL[e + 6] = __uint_as_float(rq.w << 16); qL[e + 7] = __uint_as_float(rq.w & 0xffff0000u);
      vL[e + 0] = __uint_as_float(rv.x << 16); vL[e + 1] = __uint_as_float(rv.x & 0xffff0000u);
      vL[e + 2] = __uint_as_float(rv.y << 16); vL[e + 3] = __uint_as_float(rv.y & 0xffff0000u);
      vL[e + 4] = __uint_as_float(rv.z << 16); vL[e + 5] = __uint_as_float(rv.z & 0xffff0000u);
      vL[e + 6] = __uint_as_float(rv.w << 16); vL[e + 7] = __uint_as_float(rv.w & 0xffff0000u);
      kL[e + 0] = omlb[0] * sigm(-__uint_as_float(rk.x << 16)); kL[e + 1] = omlb[1] * sigm(-__uint_as_float(rk.x & 0xffff0000u));
      kL[e + 2] = omlb[2] * sigm(-__uint_as_float(rk.y << 16)); kL[e + 3] = omlb[3] * sigm(-__uint_as_float(rk.y & 0xffff0000u));
      kL[e + 4] = omlb[4] * sigm(-__uint_as_float(rk.z << 16)); kL[e + 5] = omlb[5] * sigm(-__uint_as_float(rk.z & 0xffff0000u));
      kL[e + 6] = omlb[6] * sigm(-__uint_as_float(rk.w << 16)); kL[e + 7] = omlb[7] * sigm(-__uint_as_float(rk.w & 0xffff0000u));
    }
    __syncthreads();
    if (c + 1 < nch) {
      int t = (c + 1) * CH + lt; t = t < T ? t : T - 1;
      const size_t off = (size_t)t * 512 + h * 64 + part * 8;
      rq = *(const u32x4*)(hq + off); rk = *(const u32x4*)(hf + off); rv = *(const u32x4*)(hi + off);
    }
    const int nt = (T - c * CH) < CH ? (T - c * CH) : CH;
    for (int t = 0; t < nt; ++t) {
      const float vt = vL[t * 64 + vv];
      const f32x2 vt2 = {vt, vt};
      f32x2 o2 = {0.f, 0.f};
#pragma unroll
      for (int i4 = 0; i4 < 4; ++i4) {
        const f32x4 k4 = *(const f32x4*)(kL + t * 64 + kq * 16 + i4 * 4);
        const f32x4 q4 = *(const f32x4*)(qL + t * 64 + kq * 16 + i4 * 4);
        const f32x2 ka = {k4.x, k4.y}, kb = {k4.z, k4.w}, qa = {q4.x, q4.y}, qb2 = {q4.z, q4.w};
        S[i4 * 2 + 0] = __builtin_elementwise_fma(ka, vt2 - S[i4 * 2 + 0], S[i4 * 2 + 0]); o2 = __builtin_elementwise_fma(qa, S[i4 * 2 + 0], o2);
        S[i4 * 2 + 1] = __builtin_elementwise_fma(kb, vt2 - S[i4 * 2 + 1], S[i4 * 2 + 1]); o2 = __builtin_elementwise_fma(qb2, S[i4 * 2 + 1], o2);
      }
      const float oacc = o2.x + o2.y;
      oP[(kq * CH + t) * 64 + vv] = oacc;
    }
    __syncthreads();
    {
      const int t = c * CH + lt;
      f32x4 a0 = *(const f32x4*)(oP + (0 * CH + lt) * 64 + part * 8), a1 = *(const f32x4*)(oP + (0 * CH + lt) * 64 + part * 8 + 4);
#pragma unroll
      for (int w = 1; w < 4; ++w) { a0 += *(const f32x4*)(oP + (w * CH + lt) * 64 + part * 8); a1 += *(const f32x4*)(oP + (w * CH + lt) * 64 + part * 8 + 4); }
      float ss = dot4(a0) + dot4(a1);
      ss += __shfl_xor(ss, 1); ss += __shfl_xor(ss, 2); ss += __shfl_xor(ss, 4);
      const float r = rsqrtf(ss * (1.f / 64.f) + EPS);
      if (t < T) {
        const size_t off = (size_t)t * 512 + h * 64 + part * 8;
        const u32x4 g = *(const u32x4*)(hg + off);
        u32x4 w;
        w.x = pk2(a0.x * r * gv0.x * __uint_as_float(g.x << 16), a0.y * r * gv0.y * __uint_as_float(g.x & 0xffff0000u));
        w.y = pk2(a0.z * r * gv0.z * __uint_as_float(g.y << 16), a0.w * r * gv0.w * __uint_as_float(g.y & 0xffff0000u));
        w.z = pk2(a1.x * r * gv1.x * __uint_as_float(g.z << 16), a1.y * r * gv1.y * __uint_as_float(g.z & 0xffff0000u));
        w.w = pk2(a1.z * r * gv1.z * __uint_as_float(g.w << 16), a1.w * r * gv1.w * __uint_as_float(g.w & 0xffff0000u));
        *(u32x4*)(ob + off) = w;
      }
    }
    __syncthreads();
  }
#pragma unroll
  for (int i = 0; i < 8; ++i) { Sout[(size_t)(kq * 16 + 2 * i) * 64 + vv] = S[i].x; Sout[(size_t)(kq * 16 + 2 * i + 1) * 64 + vv] = S[i].y; }
}


#define XB_TMO      128
#define XB_XCNT(j)  (256  + 64 * (j))
#define XB_XSUB(j)  (1280 + 64 * (j))
#define XB_XGEN(j)  (2304 + 64 * (j))
#define XB_TOP      3328
#define XB_TOPGEN   3392
#define XCD_BAR_WORDS 3456
#define XB_SPIN_CAP (1u << 18)
#define LAS __attribute__((address_space(3)))
DI unsigned xb_ld(unsigned* p)              { return __hip_atomic_load(p, __ATOMIC_RELAXED, __HIP_MEMORY_SCOPE_AGENT); }
DI unsigned xb_add(unsigned* p, unsigned v) { return __hip_atomic_fetch_add(p, v, __ATOMIC_RELAXED, __HIP_MEMORY_SCOPE_AGENT); }
DI unsigned xb_xcc_id() { return (unsigned)__builtin_amdgcn_s_getreg((3 << 11) | 20) & 0xFu; }
#define XB_SPIN(cond, bar) do { unsigned _sp = 0; while (cond) { __builtin_amdgcn_s_sleep(1); \
    if ((++_sp & 255u) == 0u) { if (xb_ld(&(bar)[XB_TMO])) break; if (_sp > XB_SPIN_CAP) { atomicAdd(&(bar)[XB_TMO], 1u); break; } } } } while (0)
struct XcdBarrier { unsigned* bar; unsigned x; volatile LAS unsigned* st; };
DI XcdBarrier xcd_barrier_post(unsigned* bar, volatile LAS unsigned* st) {
    XcdBarrier b; b.bar = bar; b.x = xb_xcc_id(); b.st = st;
    if (threadIdx.x == 0) (void)xb_add(&bar[XB_XCNT(b.x)], 1u);
    return b;
}
DI void xcd_barrier_complete(unsigned* bar, unsigned x, unsigned& nloc, unsigned& nx) {
    const unsigned G = gridDim.x * gridDim.y * gridDim.z;
    unsigned sum, cnt, mine, sp = 0u;
    for (;;) {
        sum = 0u; cnt = 0u; mine = 0u;
#pragma unroll
        for (unsigned j = 0; j < 16; ++j) { const unsigned c = xb_ld(&bar[XB_XCNT(j)]); sum += c; cnt += (c > 0u) ? 1u : 0u; mine = (j == x) ? c : mine; }
        if (sum == G) break;
        __builtin_amdgcn_s_sleep(1);
        if ((++sp & 255u) == 0u) { if (xb_ld(&bar[XB_TMO])) break; if (sp > XB_SPIN_CAP) { atomicAdd(&bar[XB_TMO], 1u); break; } }
    }
    nloc = mine > 0u ? mine : 1u; nx = cnt > 0u ? cnt : 1u;
}
DI void xcd_barrier(const XcdBarrier& b) {
    asm volatile("s_waitcnt vmcnt(0)" ::: "memory");
    __syncthreads();
    if (threadIdx.x == 0) {
        unsigned* bar = b.bar;
        __builtin_amdgcn_s_waitcnt(0);
        unsigned nloc = b.st[0], nx = b.st[1];
        if (nloc == 0u) { xcd_barrier_complete(bar, b.x, nloc, nx); b.st[0] = nloc; b.st[1] = nx; }
        const unsigned old = xb_add(&bar[XB_XSUB(b.x)], 1u);
        const unsigned gen = old / nloc;
        if (old + 1u == (gen + 1u) * nloc) {
            __builtin_amdgcn_fence(__ATOMIC_RELEASE, "agent");
            asm volatile("s_waitcnt vmcnt(0)" ::: "memory");
            const unsigned og = xb_add(&bar[XB_TOP], 1u);
            const unsigned tg = og / nx;
            if (og + 1u == (tg + 1u) * nx) xb_add(&bar[XB_TOPGEN], 1u);
            else XB_SPIN(xb_ld(&bar[XB_TOPGEN]) == tg, bar);
            __builtin_amdgcn_fence(__ATOMIC_ACQUIRE, "agent");
            xb_add(&bar[XB_XGEN(b.x)], 1u);
            asm volatile("s_waitcnt vmcnt(0)" ::: "memory");
        } else {
            XB_SPIN(xb_ld(&bar[XB_XGEN(b.x)]) == gen, bar);
            __builtin_amdgcn_fence(__ATOMIC_ACQUIRE, "agent");
            asm volatile("s_waitcnt vmcnt(0)" ::: "memory");
        }
    }
    __syncthreads();
}

__global__ void __launch_bounds__(256, 2) fwd_megakernel(Params p) {
  cg::grid_group grid = cg::this_grid();
  __shared__ __attribute__((aligned(16))) char lds[LDS_BYTES];
  __shared__ int s_item;
  __shared__ uint4 xb_words;
  const int tid = opq((int)threadIdx.x), lane = tid & 63, wave = tid >> 6, wr = wave >> 1, wc = wave & 1, fr = lane & 15, fq = lane >> 4;
  const int nblk = gridDim.x, bid = blockIdx.x;
  Layout L; make_layout(p.ng, L);
  char* ws = p.ws;
  float* out = p.out;
  const int ng = p.ng, SPG = 32 / ng, TG = SPG * 2048, R = TG + 128, MTP = TG / 128;
  bf16_t* w_in = (bf16_t*)(ws + L.w_in); bf16_t* w_g = (bf16_t*)(ws + L.w_g); bf16_t* w_uq = (bf16_t*)(ws + L.w_uq);
  bf16_t* w_ukvG = (bf16_t*)(ws + L.w_ukvG); bf16_t* w_ukvP = (bf16_t*)(ws + L.w_ukvP); bf16_t* w_br = (bf16_t*)(ws + L.w_br);
  bf16_t* w_out = (bf16_t*)(ws + L.w_out); bf16_t* w_up = (bf16_t*)(ws + L.w_up); bf16_t* w_down = (bf16_t*)(ws + L.w_down);
  f32x2* rope = (f32x2*)(ws + L.rope); int* ctr = (int*)(ws + L.ctr);
  bf16_t* xb = (bf16_t*)(ws + L.xb); float* ssq0 = (float*)(ws + L.ssq0); float* ssq1 = (float*)(ws + L.ssq1);
  float* ssqq = (float*)(ws + L.ssqq); float* ssqkv = (float*)(ws + L.ssqkv);
  bf16_t* qlat = (bf16_t*)(ws + L.qlat); bf16_t* qb = (bf16_t*)(ws + L.q); bf16_t* kvlat = (bf16_t*)(ws + L.kvlat); bf16_t* krot = (bf16_t*)(ws + L.krot);
  bf16_t* knope = (bf16_t*)(ws + L.kv); bf16_t* vtM = knope + (size_t)R * 512; bf16_t* mbuf = (bf16_t*)(ws + L.kv);
  bf16_t* hq = (bf16_t*)(ws + L.hq); bf16_t* hf = (bf16_t*)(ws + L.hf); bf16_t* hi = (bf16_t*)(ws + L.hi); bf16_t* hg = (bf16_t*)(ws + L.hg);
  bf16_t* dq = (bf16_t*)(ws + L.dq); bf16_t* dk = (bf16_t*)(ws + L.dk); bf16_t* dvT = (bf16_t*)(ws + L.dvT); bf16_t* hmid = (bf16_t*)(ws + L.hq);
  bf16_t* ckvS = (bf16_t*)(ws + L.ckvS); bf16_t* knopeS = (bf16_t*)(ws + L.knopeS); bf16_t* vtMS = (bf16_t*)(ws + L.vtMS); bf16_t* krotS = (bf16_t*)(ws + L.krotS);
  bf16_t* dKS = (bf16_t*)(ws + L.dKS); bf16_t* dVtS = (bf16_t*)(ws + L.dVtS);
  char* gst = ws + L.gst + (size_t)bid * 131072;
  if (threadIdx.x == 0) xb_words = make_uint4(0u, 0u, 0u, 0u);
  __syncthreads();
  const XcdBarrier xbar = xcd_barrier_post((unsigned*)(ws + L.bar), (volatile LAS unsigned*)&xb_words);

  grid.sync();
  for (int l = 0; l < 2; ++l) {
    {
      if (PH & 1) {
      LANEVARS
      const int total2 = 68 * 16 + 48 * 16 + 12 * 6 + 16 * 4 + 16 * 4 + 3 * 16 * 8 + 16 * 16 + 88 * 16 + 16 * 44 + 8 * 8 * 32;
      for (int it = bid; it < total2; it += nblk) {
        int rem = it, job = 0;
        if (job == 0 && rem >= 68 * 16) { rem -= 68 * 16; job = 1; }
        if (job == 1 && rem >= 48 * 16) { rem -= 48 * 16; job = 2; }
        if (job == 2 && rem >= 12 * 6) { rem -= 12 * 6; job = 3; }
        if (job == 3 && rem >= 16 * 4) { rem -= 16 * 4; job = 4; }
        if (job == 4 && rem >= 16 * 4) { rem -= 16 * 4; job = 5; }
        if (job == 5 && rem >= 16 * 8) { rem -= 16 * 8; job = 6; }
        if (job == 6 && rem >= 16 * 8) { rem -= 16 * 8; job = 7; }
        if (job == 7 && rem >= 16 * 8) { rem -= 16 * 8; job = 8; }
        if (job == 8 && rem >= 16 * 16) { rem -= 16 * 16; job = 9; }
        if (job == 9 && rem >= 88 * 16) { rem -= 88 * 16; job = 10; }
        if (job == 10 && rem >= 16 * 44) { rem -= 16 * 44; job = 11; }
        const float* W; int ldw, kind, ldo, nkt; const float* ksc = nullptr; bf16_t* o;
        switch (job) {
          case 0: W = p.in[9] + (size_t)l * 1024 * 7328; ldw = 7328; ksc = p.in[8] + l * 1024; kind = 1; o = w_in; ldo = 1024; nkt = 16; break;
          case 1: W = p.in[9] + (size_t)l * 1024 * 7328; ldw = 7328; ksc = p.in[8] + l * 1024; kind = 2; o = w_g; ldo = 1024; nkt = 16; break;
          case 2: W = p.in[11] + (size_t)l * 384 * 768; ldw = 768; ksc = p.in[10] + l * 384; kind = 3; o = w_uq; ldo = 384; nkt = 6; break;
          case 3: W = p.in[13] + (size_t)l * 256 * 1024; ldw = 1024; ksc = p.in[12] + l * 256; kind = 4; o = w_ukvG; ldo = 256; nkt = 4; break;
          case 4: W = p.in[13] + (size_t)l * 256 * 1024; ldw = 1024; kind = 4; o = w_ukvP; ldo = 256; nkt = 4; break;
          case 5: W = p.in[18] + (size_t)(l * 3 + 0) * 512 * 1024; ldw = 1024; kind = 0; o = w_br; ldo = 512; nkt = 8; break;
          case 6: W = p.in[18] + (size_t)(l * 3 + 1) * 512 * 1024; ldw = 1024; kind = 0; o = w_br + (size_t)1024 * 512; ldo = 512; nkt = 8; break;
          case 7: W = p.in[18] + (size_t)(l * 3 + 2) * 512 * 1024; ldw = 1024; kind = 0; o = w_br + (size_t)2 * 1024 * 512; ldo = 512; nkt = 8; break;
          case 8: W = p.in[19] + (size_t)l * 1024 * 1024; ldw = 1024; kind = 0; o = w_out; ldo = 1024; nkt = 16; break;
          case 9: W = p.in[21] + (size_t)l * 1024 * 5632; ldw = 5632; ksc = p.in[20] + l * 1024; kind = 5; o = w_up; ldo = 1024; nkt = 16; break;
          case 10: W = p.in[24] + (size_t)l * 2816 * 1024; ldw = 1024; kind = 0; o = w_down; ldo = 2816; nkt = 44; break;
          default: { const int sb = rem >> 8; rem &= 255; W = p.in[5] + ((size_t)(l * 8 + sb) * 2048) * 512; ldw = 512; kind = 0; o = dVtS + (size_t)sb * 512 * KS_LD; ldo = KS_LD; nkt = 32; } break;
        }
        conv_tile(W, ldw, ksc, kind, o, ldo, rem / nkt, rem % nkt, lds);
      }
      const size_t gth = (size_t)bid * 256 + tid, gstride = (size_t)nblk * 256;
      for (size_t i = gth; i < (size_t)16384 * 256 / 8; i += gstride) {
        const float* s = p.in[2] + (size_t)l * 16384 * 256 + i * 8;
        const f32x4 a = *(const f32x4*)s, b = *(const f32x4*)(s + 4);
        u32x4 w; w.x = pk2(a.x, a.y); w.y = pk2(a.z, a.w); w.z = pk2(b.x, b.y); w.w = pk2(b.z, b.w);
        *(u32x4*)(ckvS + i * 8) = w;
      }
      for (size_t i = gth; i < (size_t)16384 * 512 / 8; i += gstride) {
        const size_t row = i >> 6, c8 = i & 63, sb = row >> 11, pos = row & 2047;
        const float* s = p.in[4] + ((size_t)l * 16384 + row) * 512 + c8 * 8;
        const f32x4 a = *(const f32x4*)s, b = *(const f32x4*)(s + 4);
        u32x4 w; w.x = pk2(a.x, a.y); w.y = pk2(a.z, a.w); w.z = pk2(b.x, b.y); w.w = pk2(b.z, b.w);
        *(u32x4*)(dKS + (sb * KS_LD + pos) * 512 + c8 * 8) = w;
      }
      for (size_t i = gth; i < (size_t)16384 * 32 / 8; i += gstride) {
        const size_t row = i >> 2, c8 = i & 3, sb = row >> 11, pos = row & 2047;
        const float* s = p.in[3] + ((size_t)l * 16384 + row) * 32 + c8 * 8;
        const f32x4 a = *(const f32x4*)s, b = *(const f32x4*)(s + 4);
        u32x4 w; w.x = pk2(a.x, a.y); w.y = pk2(a.z, a.w); w.z = pk2(b.x, b.y); w.w = pk2(b.z, b.w);
        *(u32x4*)(krotS + (sb * KS_LD + pos) * 32 + c8 * 8) = w;
      }
      for (size_t i = gth; i < (size_t)4096 * 6; i += gstride) {
        const size_t row = i / 6, c8 = i % 6;
        const u32x4 z = {0u, 0u, 0u, 0u};
        *(u32x4*)(dVtS + row * KS_LD + 2064 + c8 * 8) = z;
        *(u32x4*)(vtMS + row * KS_LD + 2064 + c8 * 8) = z;
      }
      if (l == 0) {
        if (bid == 0 && tid < 64) ctr[tid] = 0;
        for (size_t i = gth; i < (size_t)2064 * 16; i += gstride) {
          const int pos = (int)(i >> 4), k = (int)(i & 15);
          const float inv = powf(10000.f, -(float)k / 16.f);
          const float ang = (float)pos * inv;
          f32x2 cs; cs.x = cosf(ang); cs.y = sinf(ang);
          rope[i] = cs;
        }
        for (int row0 = bid * 8; row0 < NPTOK + NSTOK; row0 += nblk * 8) {
          f32x4 v[8];
#pragma unroll
          for (int r = 0; r < 8; ++r) {
            const int row = row0 + r;
            const float* s = row < NPTOK ? p.in[0] + (size_t)row * 1024 : p.in[1] + (size_t)(row - NPTOK) * 1024;
            v[r] = *(const f32x4*)(s + tid * 4);
          }
#pragma unroll
          for (int r = 0; r < 8; ++r) {
            const int row = row0 + r;
            *(u32x2*)(xb + (size_t)row * 1024 + tid * 4) = pk4(v[r]);
            float ss = dot4(v[r]);
            ss += __shfl_xor(ss, 1); ss += __shfl_xor(ss, 2); ss += __shfl_xor(ss, 4); ss += __shfl_xor(ss, 8);
            if ((tid & 15) == 0) ssq0[(size_t)row * 16 + (tid >> 4)] = ss;
          }
        }
      }
      }
    }
    xcd_barrier(xbar);

    const float lam_init = l == 0 ? 0.2f : (0.8f - 0.6f * 0.7408182206817179f);
    const float* resP = l == 0 ? p.in[0] : out + O_YP;
    const float* resS = l == 0 ? p.in[1] : out + O_YS;

    for (int g = 0; g < ng; ++g) {
      const int MT = MTP + (g == 0 ? 1 : 0);
      if (PH & 2) {
        const int MT2 = (MT + 1) >> 1;
        for (int it = 0; it < n_rounds(nblk, 34, MT2); ++it) {
        LANEVARS
        int pm, nt; if (!map_tile(it, bid, nblk, 34, MT2, pm, nt)) continue;
        const int mt0 = 2 * pm, mt1 = 2 * pm + 1;
        const bool two = mt1 < MT;
        const int xr0 = mt0 >= MTP ? NPTOK : g * TG + mt0 * 128;
        const int xr1 = !two ? xr0 : (mt1 >= MTP ? NPTOK : g * TG + mt1 * 128);
        f32x4 accA[4][4], accB[4][4]; zero_acc(accA); zero_acc(accB);
        gemm_pair(xb + (size_t)xr0 * 1024, xb + (size_t)xr1 * 1024, 1024, w_in + (size_t)nt * 128 * 1024, 1024, 1024, accA, accB, lds);
        auto epi = [&](const int mt, f32x4 (&acc)[4][4]) {
        const bool smp = mt >= MTP;
        int seg, segt;
        if (nt < 3) { seg = 0; segt = nt; } else if (nt < 5) { seg = 1; segt = nt - 3; } else if (nt < 33) { seg = 2 + ((nt - 5) >> 2); segt = (nt - 5) & 3; } else { seg = 9; segt = 0; }
#pragma unroll
        for (int mi = 0; mi < 4; ++mi) {
          const int rl = mt * 128 + wr * 64 + mi * 16 + fr;
          const int s = rl - TG;
          const int xrow = smp ? NPTOK + s : g * TG + rl;
          const float rs = rowscale16(ssq0, xrow);
          float ss = 0.f;
#pragma unroll
          for (int ni = 0; ni < 4; ++ni) {
            const int cc = segt * 128 + wc * 64 + ni * 16 + fq * 4;
            f32x4 v = acc[mi][ni] * rs;
            if (seg == 0) { *(u32x2*)(qlat + (size_t)rl * 384 + cc) = pk4(v); ss += dot4(v); }
            else if (seg == 1) {
              float* fo = smp ? out + O_SCKV + (size_t)(l * NSTOK + s) * 256 + cc : out + O_PCKV + ((size_t)l * NPTOK + xrow) * 256 + cc;
              *(f32x4*)fo = v;
              *(u32x2*)(kvlat + (size_t)rl * 256 + cc) = pk4(v); ss += dot4(v);
            } else if (seg == 2) { v.x = silu(v.x); v.y = silu(v.y); v.z = silu(v.z); v.w = silu(v.w); *(u32x2*)(hq + (size_t)rl * 512 + cc) = pk4(v); }
            else if (seg == 3) { *(u32x2*)(hf + (size_t)rl * 512 + cc) = pk4(v); }
            else if (seg == 4) { *(u32x2*)(hi + (size_t)rl * 512 + cc) = pk4(v); }
            else if (seg == 5) { v.x = silu(v.x); v.y = silu(v.y); v.z = silu(v.z); v.w = silu(v.w); *(u32x2*)(hg + (size_t)rl * 512 + cc) = pk4(v); }
            else if (seg == 6) { *(u32x2*)(dq + (size_t)rl * 512 + cc) = pk4(v * QS_DF); }
            else if (seg == 7) {
              float* fo = smp ? out + O_SDK + (size_t)(l * NSTOK + s) * 512 + cc : out + O_PDK + ((size_t)l * NPTOK + xrow) * 512 + cc;
              *(f32x4*)fo = v;
              bf16_t* bo = smp ? dKS + ((size_t)(s >> 4) * KS_LD + 2048 + (s & 15)) * 512 + cc : dk + (size_t)rl * 512 + cc;
              *(u32x2*)bo = pk4(v);
            } else if (seg == 8) {
              float* fo = smp ? out + O_SDV + (size_t)(l * NSTOK + s) * 512 + cc : out + O_PDV + ((size_t)l * NPTOK + xrow) * 512 + cc;
              *(f32x4*)fo = v;
              const int hh = cc >> 6, d = cc & 63;
              bf16_t* bo; size_t ld;
              if (smp) { bo = dVtS + ((size_t)((s >> 4) * 8 + hh) * 64 + d) * KS_LD + 2048 + (s & 15); ld = KS_LD; }
              else { bo = dvT + ((size_t)((rl >> 11) * 8 + hh) * 64 + d) * 2048 + (rl & 2047); ld = 2048; }
              const u32x2 w = pk4(v);
              bo[0] = (bf16_t)(w.x & 0xffff); bo[ld] = (bf16_t)(w.x >> 16); bo[2 * ld] = (bf16_t)(w.y & 0xffff); bo[3 * ld] = (bf16_t)(w.y >> 16);
            } else {
              if (cc < 32) {
                float* fo = smp ? out + O_SKR + (size_t)(l * NSTOK + s) * 32 + cc : out + O_PKR + ((size_t)l * NPTOK + xrow) * 32 + cc;
                *(f32x4*)fo = v;
              }
            }
          }
          if (seg <= 1) {
            ss = quadsum(ss);
            if (fq == 0) { if (seg == 0) ssqq[(size_t)rl * 8 + segt * 2 + wc] = ss; else ssqkv[(size_t)rl * 4 + segt * 2 + wc] = ss; }
          }
        }
        };
        epi(mt0, accA);
        if (two) epi(mt1, accB);
        }
      }
      xcd_barrier(xbar);

      if (PH & 4) for (int row = bid * 4 + opq((int)(threadIdx.x >> 6)); row < (g == 0 ? R : TG); row += nblk * 4) {
        LANEVARS
        const bool smp = row >= TG;
        const int s = row - TG;
        const size_t gt = (size_t)g * TG + row;
        float* ck = smp ? out + O_SCKV + (size_t)(l * NSTOK + s) * 256 : out + O_PCKV + ((size_t)l * NPTOK + gt) * 256;
        const float r = rowscale_kv(ssqkv, row);
        const f32x4 v = *(const f32x4*)(ck + lane * 4), g4 = *(const f32x4*)(p.in[12] + l * 256 + lane * 4);
        *(f32x4*)(ck + lane * 4) = v * r * g4;
        if (lane < 16) {
          float* kr = smp ? out + O_SKR + (size_t)(l * NSTOK + s) * 32 : out + O_PKR + ((size_t)l * NPTOK + gt) * 32;
          const int pos = smp ? 2048 + (s & 15) : (row & 2047);
          const float x1 = kr[lane], x2 = kr[lane + 16];
          const f32x2 cs = rope[pos * 16 + lane];
          const float o1 = x1 * cs.x - x2 * cs.y, o2 = x2 * cs.x + x1 * cs.y;
          kr[lane] = o1; kr[lane + 16] = o2;
          bf16_t* kb = smp ? krotS + ((size_t)(s >> 4) * KS_LD + 2048 + (s & 15)) * 32 : krot + (size_t)row * 32;
          kb[lane] = (bf16_t)(pk2(o1, 0.f) & 0xffff); kb[lane + 16] = (bf16_t)(pk2(o2, 0.f) & 0xffff);
        }
      }
      if (PH & 4) for (int it = 0; it < n_rounds(nblk, 6, MT); ++it) {
        LANEVARS
        int mt, nt; if (!map_tile(it, bid, nblk, 6, MT, mt, nt)) continue;
        const bool smp = mt >= MTP;
        f32x4 acc[4][4]; zero_acc(acc);
        gemm_tile<false>(qlat + (size_t)mt * 128 * 384, 384, w_uq + (size_t)nt * 128 * 384, 384, 384, acc, lds);
#pragma unroll
        for (int mi = 0; mi < 4; ++mi) {
          const int rl = mt * 128 + wr * 64 + mi * 16 + fr;
          const f32x4 a = *(const f32x4*)(ssqq + (size_t)rl * 8); const f32x2 b = *(const f32x2*)(ssqq + (size_t)rl * 8 + 4);
          const float rq = rsqrtf((((a.x + a.y) + (a.z + a.w)) + (b.x + b.y)) * (1.f / 384.f) + EPS) * QS_MLA;
          bf16_t* qrow = qb + (size_t)rl * 768 + nt * 128 + wc * 64 + fq * 4;
          if (nt < 4) {
#pragma unroll
            for (int ni = 0; ni < 4; ++ni) *(u32x2*)(qrow + ni * 16) = pk4(acc[mi][ni] * rq);
          } else {
            const int pos = smp ? 2048 + ((rl - TG) & 15) : (rl & 2047);
            const f32x4 c01 = *(const f32x4*)(rope + pos * 16 + fq * 4), c23 = *(const f32x4*)(rope + pos * 16 + fq * 4 + 2);
            const f32x4 cs = {c01.x, c01.z, c23.x, c23.z}, sn = {c01.y, c01.w, c23.y, c23.w};
#pragma unroll
            for (int np = 0; np < 2; ++np) {
              const f32x4 lo = acc[mi][2 * np] * rq, hi2 = acc[mi][2 * np + 1] * rq;
              *(u32x2*)(qrow + (2 * np) * 16) = pk4(lo * cs - hi2 * sn);
              *(u32x2*)(qrow + (2 * np + 1) * 16) = pk4(hi2 * cs + lo * sn);
            }
          }
        }
      }
      if (PH & 8) {
        const int MTK = MT + (g == 0 ? 128 : 0);
        for (int it = 0; it < n_rounds(nblk, 8, MTK); ++it) {
          LANEVARS
          int mt, nt; if (!map_tile(it, bid, nblk, 8, MTK, mt, nt)) continue;
          const bool past = mt >= MT;
          const bool smp = !past && mt >= MTP;
          const int pm = mt - MT;
          const bf16_t* A = past ? ckvS + (size_t)pm * 128 * 256 : kvlat + (size_t)mt * 128 * 256;
          const bf16_t* W = (past ? w_ukvP : w_ukvG) + (size_t)nt * 128 * 256;
          f32x4 acc[4][4]; zero_acc(acc);
          if (nt < 4) {
            gemm_tile<false>(A, 256, W, 256, 256, acc, lds);
#pragma unroll
            for (int mi = 0; mi < 4; ++mi) {
              const int rt = wr * 64 + mi * 16 + fr;
              const int rl = mt * 128 + rt;
              const float r = past ? 1.f : rowscale_kv(ssqkv, rl);
              bf16_t* dst;
              if (past) dst = knopeS + ((size_t)(pm >> 4) * KS_LD + (pm & 15) * 128 + rt) * 512;
              else if (smp) dst = knopeS + ((size_t)(rt >> 4) * KS_LD + 2048 + (rt & 15)) * 512;
              else dst = knope + (size_t)rl * 512;
              dst += nt * 128 + wc * 64 + fq * 4;
#pragma unroll
              for (int ni = 0; ni < 4; ++ni) *(u32x2*)(dst + ni * 16) = pk4(acc[mi][ni] * r);
            }
          } else {
            gemm_tile<true>(A, 256, W, 256, 256, acc, lds);
#pragma unroll
            for (int mi = 0; mi < 4; ++mi) {
              const int rt = wr * 64 + mi * 16 + fq * 4;
              const int rl = mt * 128 + rt;
              f32x4 r4 = {1.f, 1.f, 1.f, 1.f};
              if (!past) { r4.x = rowscale_kv(ssqkv, rl); r4.y = rowscale_kv(ssqkv, rl + 1); r4.z = rowscale_kv(ssqkv, rl + 2); r4.w = rowscale_kv(ssqkv, rl + 3); }
#pragma unroll
              for (int ni = 0; ni < 4; ++ni) {
                const int n = (nt - 4) * 128 + wc * 64 + ni * 16 + fr;
                bf16_t* dst;
                if (past) dst = vtMS + ((size_t)(pm >> 4) * 512 + n) * KS_LD + (pm & 15) * 128 + rt;
                else if (smp) dst = vtMS + ((size_t)(rt >> 4) * 512 + n) * KS_LD + 2048 + (rt & 15);
                else dst = vtM + ((size_t)(rl >> 11) * 512 + n) * 2048 + (rl & 2047);
                *(u32x2*)dst = pk4(acc[mi][ni] * r4);
              }
            }
          }
        }
      }
      xcd_barrier(xbar);

      if (PH & 16) {
        LANEVARS
        const int n_hg = SPG * 8 + (g == 0 ? 64 : 0);
        const int n_sa = g == 0 ? 128 : 0;
        const int n_items = n_hg + n_sa + 16 * SPG * 16;
        int* my_ctr = ctr + l * 8 + g;
        float lam = 0.f;
        {
          const float* dl = p.in[16] + l * 128;
          float s1 = 0.f, s2 = 0.f;
          for (int i = 0; i < 32; ++i) { s1 += dl[i] * dl[32 + i]; s2 += dl[64 + i] * dl[96 + i]; }
          lam = __expf(s1) - __expf(s2) + lam_init;
        }
        for (int pass = DRY4 ? 0 : 1; pass < 2; ++pass) {
        const bool dry = pass == 0;
        bf16_t* dryb = (bf16_t*)(ws + L.total);
        if (dry) my_ctr += 32; else if (DRY4) my_ctr -= 32;
        for (;;) {
          if (tid == 0) s_item = atomicAdd(my_ctr, 1);
          __syncthreads();
          int it = s_item;
          __syncthreads();
          if (it >= n_items) break;
          if (it < n_hg) {
            if (it < SPG * 8) {
              const int lb = it >> 3, h = it & 7, b = g * SPG + lb;
              const size_t ro = (size_t)lb * 2048 * 512;
              hgrn_unit(hq + ro, (dry ? dryb : hq) + ro, hf + ro, hi + ro, hg + ro, h, 2048, nullptr, dry ? (float*)dryb : out + O_PHG + ((size_t)(l * 32 + b) * 8 + h) * 4096, p.in[14], l, p.in[15] + l * 64, lds);
            } else {
              const int u = it - SPG * 8, sb = u >> 3, h = u & 7;
              const size_t ro = (size_t)(TG + sb * 16) * 512;
              hgrn_unit(hq + ro, (dry ? dryb : hq) + ro, hf + ro, hi + ro, hg + ro, h, 16, p.in[6] + ((size_t)(l * 8 + sb) * 8 + h) * 4096, dry ? (float*)dryb : out + O_SHG + ((size_t)(l * 8 + sb) * 8 + h) * 4096, p.in[14], l, p.in[15] + l * 64, lds);
            }
            continue;
          }
          it -= n_hg;
          if (it < n_sa) {
            const int type = it & 1, h = (it >> 1) & 7, sb = it >> 4;
            const size_t r0 = (size_t)TG + sb * 16;
            const int wl = wave == 0 ? 33 : 0;
            if (type == 0)
              attn_item<0>(qb + r0 * 768 + h * 64, qb + r0 * 768 + 512 + h * 32, 768, knopeS + (size_t)sb * KS_LD * 512 + h * 64, krotS + (size_t)sb * KS_LD * 32,
                           vtMS + (size_t)(sb * 8 + h) * 64 * KS_LD, KS_LD, (dry ? dryb : qb) + r0 * 768 + h * 64, 768, 16, 33, wl, 16, 0.f, 1.f, nullptr, lds);
            else
              attn_item<1>(dq + r0 * 512 + h * 64, nullptr, 512, dKS + (size_t)sb * KS_LD * 512 + h * 64, nullptr,
                           dVtS + (size_t)(sb * 8 + h) * 64 * KS_LD, KS_LD, (dry ? dryb : dq) + r0 * 512 + h * 64, 512, 16, 33, wl, 16, lam, 1.f - lam_init, p.in[17] + l * 64, lds);
            continue;
          }
          it -= n_sa;
          {
            const int per = SPG * 16;
            const int qblk = 15 - it / per, rem = it % per;
            const int type = rem & 1, h = (rem >> 1) & 7, lb = rem >> 4;
            const size_t r0 = (size_t)lb * 2048 + qblk * 128, k0 = (size_t)lb * 2048;
            const int ntl = 2 * qblk + 2, wl = wave < 2 ? ntl - 1 : ntl;
            if (type == 0)
              attn_item<0>(qb + r0 * 768 + h * 64, qb + r0 * 768 + 512 + h * 32, 768, knope + k0 * 512 + h * 64, krot + k0 * 32,
                           vtM + (size_t)(lb * 8 + h) * 64 * 2048, 2048, (dry ? dryb : qb) + r0 * 768 + h * 64, 768, 128, ntl, wl, 64, 0.f, 1.f, nullptr, lds);
            else
              attn_item<1>(dq + r0 * 512 + h * 64, nullptr, 512, dk + k0 * 512 + h * 64, nullptr,
                           dvT + (size_t)(lb * 8 + h) * 64 * 2048, 2048, (dry ? dryb : dq) + r0 * 512 + h * 64, 512, 128, ntl, wl, 64, lam, 1.f - lam_init, p.in[17] + l * 64, lds);
          }
        }
        }
      }
      xcd_barrier(xbar);

      if (PH & 32) {
        const int NU = (MTP >> 1) + (g == 0 ? 1 : 0);
        for (int it = 0; it < n_rounds(nblk, 8, NU); ++it) {
          LANEVARS
          int unit, nt; if (!map_tile(it, bid, nblk, 8, NU, unit, nt)) continue;
          const bool single = unit >= (MTP >> 1);
          const int mt0 = single ? MTP : 2 * unit;
          char* sbase = gst + (tid >> 2) * 2048 + (tid & 3) * 8;
          auto gate_epi = [&](const int s, const int mt, f32x4 (&acc)[4][4]) {
            const int xr = (mt >= MTP ? NPTOK : g * TG + mt * 128) + opq(wr * 64 + fr);
            char* sb = gst + opq((tid >> 2) * 2048 + (tid & 3) * 8);
#pragma unroll
            for (int mi = 0; mi < 4; ++mi) {
              const float rsv = rowscale16(ssq0, xr + mi * 16);
#pragma unroll
              for (int ni = 0; ni < 4; ++ni) {
                f32x4 v = acc[mi][ni] * rsv;
                v.x = sigm(v.x); v.y = sigm(v.y); v.z = sigm(v.z); v.w = sigm(v.w);
                *(u32x2*)(sb + s * 512 + (mi * 4 + ni) * 32) = pk4(v);
              }
            }
          };
          auto sum_epi = [&](const int s, const int mt, const int n, f32x4 (&acc)[4][4]) {
            const int rowq = opq(wr * 64 + fr);
            char* sb = gst + opq((tid >> 2) * 2048 + (tid & 3) * 8);
#pragma unroll
            for (int mi = 0; mi < 4; ++mi)
#pragma unroll
              for (int ni = 0; ni < 4; ++ni) {
                const u32x2 w = *(const u32x2*)(sb + s * 512 + (mi * 4 + ni) * 32);
                f32x4 gg; gg.x = __uint_as_float(w.x << 16); gg.y = __uint_as_float(w.x & 0xffff0000u); gg.z = __uint_as_float(w.y << 16); gg.w = __uint_as_float(w.y & 0xffff0000u);
                f32x4 t = gg * acc[mi][ni];
                char* ts = sb + 1024 + s * 512 + (mi * 4 + ni) * 32;
                if (n > 0) { const u32x2 pw = *(const u32x2*)ts; t.x += __uint_as_float(pw.x << 16); t.y += __uint_as_float(pw.x & 0xffff0000u); t.z += __uint_as_float(pw.y << 16); t.w += __uint_as_float(pw.y & 0xffff0000u); }
                if (n < 2) *(u32x2*)ts = pk4(t);
                else *(u32x2*)(mbuf + (size_t)(mt * 128 + rowq + mi * 16) * 1024 + nt * 128 + wc * 64 + ni * 16 + fq * 4) = pk4(t);
              }
          };
          const int xr0 = single ? NPTOK : g * TG + mt0 * 128;
#pragma unroll 1
          for (int n = 0; n < 3; ++n) {
            const bf16_t* Abr = n == 0 ? qb : (n == 1 ? hq : dq);
            const int ldbr = n == 0 ? 768 : 512;
            if (single) {
              f32x4 acc[4][4]; zero_acc(acc);
              gemm_tile<false>(xb + (size_t)xr0 * 1024, 1024, w_g + ((size_t)n * 1024 + nt * 128) * 1024, 1024, 1024, acc, lds);
              gate_epi(0, mt0, acc);
              zero_acc(acc);
              gemm_tile<false>(Abr + (size_t)mt0 * 128 * ldbr, ldbr, w_br + ((size_t)n * 1024 + nt * 128) * 512, 512, 512, acc, lds);
              sum_epi(0, mt0, n, acc);
            } else {
              f32x4 accA[4][4], accB[4][4]; zero_acc(accA); zero_acc(accB);
              gemm_pair<false>(xb + (size_t)xr0 * 1024, xb + (size_t)(single ? xr0 : xr0 + 128) * 1024, 1024, w_g + ((size_t)n * 1024 + nt * 128) * 1024, 1024, 1024, accA, accB, lds);
              gate_epi(0, mt0, accA);
              if (!single) gate_epi(1, mt0 + 1, accB);
              zero_acc(accA); zero_acc(accB);
              gemm_pair<false>(Abr + (size_t)mt0 * 128 * ldbr, Abr + (size_t)(single ? mt0 : mt0 + 1) * 128 * ldbr, ldbr, w_br + ((size_t)n * 1024 + nt * 128) * 512, 512, 512, accA, accB, lds);
              sum_epi(0, mt0, n, accA);
              if (!single) sum_epi(1, mt0 + 1, n, accB);
            }
          }
        }
      }
      xcd_barrier(xbar);

      if (PH & 64) {
        const int NU = (MTP >> 1) + (g == 0 ? 1 : 0);
        for (int it = 0; it < n_rounds(nblk, 8, NU); ++it) {
        LANEVARS
        int unit, nt; if (!map_tile(it, bid, nblk, 8, NU, unit, nt)) continue;
        auto epi = [&](const int mt, f32x4 (&acc)[4][4]) {
        const bool smp = mt >= MTP;
        const int xrow0 = smp ? NPTOK : g * TG + mt * 128;
#pragma unroll
        for (int mi = 0; mi < 4; ++mi) {
          const int rt = wr * 64 + mi * 16 + fr, xrow = xrow0 + rt, col = nt * 128 + wc * 64 + fq * 4;
          const float* rp = smp ? resS + (size_t)rt * 1024 + col : resP + (size_t)xrow * 1024 + col;
          float ss = 0.f;
#pragma unroll
          for (int ni = 0; ni < 4; ++ni) {
            const f32x4 x = *(const f32x4*)(rp + ni * 16) + acc[mi][ni];
            *(f32x4*)(out + (size_t)xrow * 1024 + col + ni * 16) = x;
            *(u32x2*)(xb + (size_t)xrow * 1024 + col + ni * 16) = pk4(x);
            ss += dot4(x);
          }
          ss = quadsum(ss);
          if (fq == 0) ssq1[(size_t)xrow * 16 + nt * 2 + wc] = ss;
        }
        };
        if (unit >= (MTP >> 1)) {
          const int mt = MTP;
          f32x4 acc[4][4]; zero_acc(acc);
          gemm_tile<false>(mbuf + (size_t)mt * 128 * 1024, 1024, w_out + (size_t)nt * 128 * 1024, 1024, 1024, acc, lds);
          epi(mt, acc);
        } else {
          const int mt = 2 * unit;
          f32x4 accA[4][4], accB[4][4]; zero_acc(accA); zero_acc(accB);
          gemm_pair<false>(mbuf + (size_t)mt * 128 * 1024, mbuf + (size_t)(mt + 1) * 128 * 1024, 1024, w_out + (size_t)nt * 128 * 1024, 1024, 1024, accA, accB, lds);
          epi(mt, accA);
          epi(mt + 1, accB);
        }
        }
      }
      xcd_barrier(xbar);

      if (PH & 128) {
        const int MT7 = SPG * 9 + (g == 0 ? 1 : 0);
        float* AL = (float*)lds;
        const float* cw = p.in[22] + (size_t)l * 3 * DFF;
        const float* cb = p.in[23] + (size_t)l * DFF;
        for (int it = 0; it < n_rounds(nblk, 44, MT7); ++it) {
          LANEVARS
          int unit, j; if (!map_tile(it, bid, nblk, 44, MT7, unit, j)) continue;
          const bool smp = unit >= SPG * 9;
          const int sq = smp ? 0 : unit / 9, uu = smp ? 0 : unit % 9;
          const int xbase = smp ? NPTOK : g * TG + sq * 2048;
          auto epi7 = [&](const int m, f32x4 (&acc)[4][4]) {
          const int t0 = smp ? 0 : 126 * m - 2;
          if (smp) {
#pragma unroll
            for (int i = 0; i < 4; ++i) { const int e = tid + i * 256, sb = e >> 7, rr = (e >> 6) & 1, f = e & 63; AL[(sb * 18 + rr) * 68 + f] = p.in[7][((size_t)(l * 8 + sb) * 2 + rr) * DFF + j * 64 + f]; }
          }
          float rs[4];
#pragma unroll
          for (int mi = 0; mi < 4; ++mi) {
            const int rt = wr * 64 + mi * 16 + fr;
            const int t = t0 + rt;
            const int tc = t < 0 ? 0 : (t > 2047 ? 2047 : t);
            rs[mi] = rowscale16(ssq1, smp ? xbase + rt : xbase + tc);
            const int lr = smp ? (rt >> 4) * 18 + 2 + (rt & 15) : rt;
#pragma unroll
            for (int np = 0; np < 2; ++np) {
              f32x4 a = acc[mi][2 * np] * rs[mi];
              if (!smp && t < 0) a = (f32x4){0.f, 0.f, 0.f, 0.f};
              const int fl = wc * 32 + np * 16 + fq * 4;
              *(f32x4*)(AL + lr * 68 + fl) = a;
              if (smp) { if ((rt & 15) >= 14) *(f32x4*)(out + O_SCONV + ((size_t)(l * 8 + (rt >> 4)) * 2 + ((rt & 15) - 14)) * DFF + j * 64 + fl) = a; }
              else if (m == 16 && (t == 2046 || t == 2047)) *(f32x4*)(out + O_PCONV + ((size_t)(l * 32 + g * SPG + sq) * 2 + (t - 2046)) * DFF + j * 64 + fl) = a;
            }
          }
          __syncthreads();
#pragma unroll
          for (int np = 0; np < 2; ++np) {
            const int fl = wc * 32 + np * 16 + fq * 4, f = j * 64 + fl;
            const f32x4 w0 = *(const f32x4*)(cw + f), w1 = *(const f32x4*)(cw + DFF + f), w2 = *(const f32x4*)(cw + 2 * DFF + f), b4 = *(const f32x4*)(cb + f);
#pragma unroll
            for (int mi = 0; mi < 4; ++mi) {
              const int rt = wr * 64 + mi * 16 + fr;
              const int t = t0 + rt;
              const bool valid = smp ? true : (rt >= 2 && t <= 2047);
              if (valid) {
                const int lr = smp ? (rt >> 4) * 18 + 2 + (rt & 15) : rt;
                const f32x4 a0 = *(const f32x4*)(AL + (lr - 2) * 68 + fl), a1 = *(const f32x4*)(AL + (lr - 1) * 68 + fl), a2 = *(const f32x4*)(AL + lr * 68 + fl);
                f32x4 c = b4 + w0 * a0 + w1 * a1 + w2 * a2;
                c.x = silu(c.x); c.y = silu(c.y); c.z = silu(c.z); c.w = silu(c.w);
                const f32x4 hv = c * (acc[mi][2 * np + 1] * rs[mi]);
                const size_t hrow = smp ? (size_t)TG + rt : (size_t)sq * 2048 + t;
                *(u32x2*)(hmid + hrow * DFF + f) = pk4(hv);
              }
            }
          }
          __syncthreads();
          };
          if (smp || uu == 8) {
            const int m = smp ? 0 : 16;
            f32x4 acc[4][4]; zero_acc(acc);
            gemm_tile<false, true>(xb + (size_t)xbase * 1024, 1024, w_up + (size_t)j * 128 * 1024, 1024, 1024, acc, lds, smp ? 0 : 126 * m - 2, 0, smp ? 127 : 2047);
            epi7(m, acc);
          } else {
            const int m0 = 2 * uu, m1 = 2 * uu + 1;
            f32x4 accA[4][4], accB[4][4]; zero_acc(accA); zero_acc(accB);
            gemm_pair<true>(xb + (size_t)xbase * 1024, xb + (size_t)xbase * 1024, 1024, w_up + (size_t)j * 128 * 1024, 1024, 1024, accA, accB, lds, 126 * m0 - 2, 126 * m1 - 2, 0, 2047);
            epi7(m0, accA);
            epi7(m1, accB);
          }
        }
      }
      xcd_barrier(xbar);

      if (PH & 256) {
        const int NU = (MTP >> 1) + (g == 0 ? 1 : 0);
        for (int it = 0; it < n_rounds(nblk, 8, NU); ++it) {
        LANEVARS
        int unit, nt; if (!map_tile(it, bid, nblk, 8, NU, unit, nt)) continue;
        auto epi = [&](const int mt, f32x4 (&acc)[4][4]) {
        const bool smp = mt >= MTP;
        const int xrow0 = smp ? NPTOK : g * TG + mt * 128;
#pragma unroll
        for (int mi = 0; mi < 4; ++mi) {
          const int rt = wr * 64 + mi * 16 + fr, xrow = xrow0 + rt, col = nt * 128 + wc * 64 + fq * 4;
          float* rp = out + (size_t)xrow * 1024 + col;
          float ss = 0.f;
#pragma unroll
          for (int ni = 0; ni < 4; ++ni) {
            const f32x4 x = *(const f32x4*)(rp + ni * 16) + acc[mi][ni];
            *(f32x4*)(rp + ni * 16) = x;
            *(u32x2*)(xb + (size_t)xrow * 1024 + col + ni * 16) = pk4(x);
            ss += dot4(x);
          }
          ss = quadsum(ss);
          if (fq == 0) ssq0[(size_t)xrow * 16 + nt * 2 + wc] = ss;
        }
        };
        if (unit >= (MTP >> 1)) {
          const int mt = MTP;
          f32x4 acc[4][4]; zero_acc(acc);
          gemm_tile<false>(hmid + (size_t)mt * 128 * DFF, DFF, w_down + (size_t)nt * 128 * DFF, DFF, DFF, acc, lds);
          epi(mt, acc);
        } else {
          const int mt = 2 * unit;
          f32x4 accA[4][4], accB[4][4]; zero_acc(accA); zero_acc(accB);
          gemm_pair<false>(hmid + (size_t)mt * 128 * DFF, hmid + (size_t)(mt + 1) * 128 * DFF, DFF, w_down + (size_t)nt * 128 * DFF, DFF, DFF, accA, accB, lds);
          epi(mt, accA);
          epi(mt + 1, accB);
        }
        }
      }
      xcd_barrier(xbar);
    }
  }
  {
    const int tid = opq((int)threadIdx.x);
    const f32x4 g4 = *(const f32x4*)(p.in[25] + tid * 4);
    for (int row0 = bid * 8; row0 < NPTOK + NSTOK; row0 += nblk * 8) {
      f32x4 v[8]; float r[8];
#pragma unroll
      for (int k = 0; k < 8; ++k) { v[k] = *(const f32x4*)(out + (size_t)(row0 + k) * 1024 + tid * 4); r[k] = rowscale16(ssq0, row0 + k); }
#pragma unroll
      for (int k = 0; k < 8; ++k) *(f32x4*)(out + (size_t)(row0 + k) * 1024 + tid * 4) = v[k] * r[k] * g4;
    }
  }
}

extern "C" void kernel_launch(void* const* d_in, const int* in_sizes, int n_in, void* d_out, int out_size, void* d_ws, size_t ws_size, hipStream_t stream) {
  static int grid_blocks = 0;
  if (!grid_blocks) {
    int dev = 0, cus = 0, per = 0;
    (void)hipGetDevice(&dev);
    (void)hipDeviceGetAttribute(&cus, hipDeviceAttributeMultiprocessorCount, dev);
    (void)hipOccupancyMaxActiveBlocksPerMultiprocessor(&per, fwd_megakernel, 256, 0);
    grid_blocks = cus * per;
    if (grid_blocks > MAXGRID) grid_blocks = MAXGRID;
    if (grid_blocks < 1) grid_blocks = 1;
  }
  Params p{};
  for (int i = 0; i < 26; ++i) p.in[i] = (const float*)d_in[i];
  p.out = (float*)d_out;
  p.ws = (char*)d_ws;
  int ng = 1;
  for (; ng < 8; ng *= 2) { Layout L; make_layout(ng, L); if (L.total + (DRY4 ? (size_t)70000 * 1536 : 0) <= ws_size) break; }
  p.ng = ng;
  p.pad = 0;
  { Layout L; make_layout(ng, L); (void)hipMemsetAsync((char*)d_ws + L.bar, 0, XCD_BAR_WORDS * 4, stream); }
  void* args[] = {&p};
  hipError_t e = hipLaunchCooperativeKernel((void*)fwd_megakernel, dim3(grid_blocks), dim3(256), args, 0, stream);
  if (e != hipSuccess) fprintf(stderr, "cooperative launch failed: %s (grid %d)\n", hipGetErrorString(e), grid_blocks);
}
```
